# Optimizing an MI355X kernel written in HIP

```python
import math
import jax, jax.numpy as jnp
from jax import lax
import numpy as np

D_MODEL = 4096
BATCH = 4
SEQ = 2048
DEPTH = 2
DEC_BATCH = 32
DEC_SEQ = 1
PAST_LEN = 16384
PAGE_SIZE = 128

N_MIXERS = 2
WINDOW = 128
ATTN_HEAD_DIM = 64
N_Q_HEADS = D_MODEL // ATTN_HEAD_DIM
N_KV_HEADS = N_Q_HEADS // 8
Q_PER_KV = N_Q_HEADS // N_KV_HEADS
Q_DIM = N_Q_HEADS * ATTN_HEAD_DIM
KV_DIM = N_KV_HEADS * ATTN_HEAD_DIM
QKV_DIM = Q_DIM + 2 * KV_DIM
HGRN_EXPAND = 128
HGRN_HEADS = D_MODEL // HGRN_EXPAND
HGRN_KEY_DIM = HGRN_EXPAND
HGRN_VAL_DIM = D_MODEL // HGRN_HEADS
HGRN_CHUNK = 64
D_FF = -(-8 * D_MODEL // (3 * 256)) * 256
N_ATTN_LAYERS = (DEPTH + 1) // 2
N_HGRN_LAYERS = DEPTH // 2
RMS_EPS = 1e-5

kernel_name = "hybrid_swa_sink_hgrn2_decode_step"


def rmsnorm(x, w):
    xf = x.astype(jnp.float32)
    y = xf * lax.rsqrt(jnp.mean(xf * xf, axis=-1, keepdims=True) + RMS_EPS)
    return (y * w.astype(jnp.float32)).astype(x.dtype)


def sink_softmax_weights(s, sink):
    m = jnp.maximum(jnp.max(s, axis=-1, keepdims=True), sink)
    e = jnp.exp(s - m)
    den = jnp.sum(e, axis=-1, keepdims=True) + jnp.exp(sink - m)
    return e / den


def split_qkv(xn, w_qkv, b_qkv):
    B, L, _ = xn.shape
    qkv = xn @ w_qkv + b_qkv
    q = qkv[..., :Q_DIM].reshape(B, L, N_KV_HEADS, Q_PER_KV, ATTN_HEAD_DIM)
    k = qkv[..., Q_DIM:Q_DIM + KV_DIM].reshape(B, L, N_KV_HEADS, ATTN_HEAD_DIM)
    v = qkv[..., Q_DIM + KV_DIM:].reshape(B, L, N_KV_HEADS, ATTN_HEAD_DIM)
    return q, k, v


def swa_prompt(xn, w_qkv, b_qkv, sinks, w_o, b_o):
    B, S, _ = xn.shape
    NB = S // WINDOW
    q, k, v = split_qkv(xn, w_qkv, b_qkv)
    qb = q.reshape(B, NB, WINDOW, N_KV_HEADS, Q_PER_KV, ATTN_HEAD_DIM)
    kb = k.reshape(B, NB, WINDOW, N_KV_HEADS, ATTN_HEAD_DIM)
    vb = v.reshape(B, NB, WINDOW, N_KV_HEADS, ATTN_HEAD_DIM)
    zk = jnp.zeros_like(kb[:, :1])
    kk = jnp.concatenate([jnp.concatenate([zk, kb[:, :-1]], axis=1), kb], axis=2)
    vv = jnp.concatenate([jnp.concatenate([zk, vb[:, :-1]], axis=1), vb], axis=2)
    scale = ATTN_HEAD_DIM ** -0.5
    s = jnp.einsum('bnqhgd,bnkhd->bnhgqk', qb, kk, preferred_element_type=jnp.float32) * scale
    qi = jnp.arange(WINDOW)[:, None]
    kj = jnp.arange(2 * WINDOW)[None, :]
    diff = qi + WINDOW - kj
    band = (diff >= 0) & (diff < WINDOW)
    valid_key = (jnp.arange(NB)[:, None, None] > 0) | (kj >= WINDOW)[None]
    mask = band[None] & valid_key
    s = jnp.where(mask[None, :, None, None], s, -jnp.inf)
    sink = sinks.astype(jnp.float32).reshape(N_KV_HEADS, Q_PER_KV, 1, 1)
    p = sink_softmax_weights(s, sink)
    o = jnp.einsum('bnhgqk,bnkhd->bnqhgd', p, vv.astype(jnp.float32))
    o = o.reshape(B, S, Q_DIM).astype(xn.dtype)
    return o @ w_o + b_o, k[:, -WINDOW:], v[:, -WINDOW:]


def swa_sample(xn, ck, cv, w_qkv, b_qkv, sinks, w_o, b_o):
    B, L, _ = xn.shape
    q, k, v = split_qkv(xn, w_qkv, b_qkv)
    kk = jnp.concatenate([ck.astype(k.dtype), k], axis=1)
    vv = jnp.concatenate([cv.astype(v.dtype), v], axis=1)
    scale = ATTN_HEAD_DIM ** -0.5
    s = jnp.einsum('blhgd,bkhd->bhglk', q, kk, preferred_element_type=jnp.float32) * scale
    diff = (jnp.arange(L)[:, None] + WINDOW) - jnp.arange(WINDOW + L)[None, :]
    mask = (diff >= 0) & (diff < WINDOW)
    s = jnp.where(mask, s, -jnp.inf)
    sink = sinks.astype(jnp.float32).reshape(N_KV_HEADS, Q_PER_KV, 1, 1)
    p = sink_softmax_weights(s, sink)
    o = jnp.einsum('bhglk,bkhd->blhgd', p, vv.astype(jnp.float32))
    o = o.reshape(B, L, Q_DIM).astype(xn.dtype)
    return o @ w_o + b_o, kk[:, -WINDOW:], vv[:, -WINDOW:]


def gla_chunked(q, k, v, log_f, s0):
    B, L, H, K = q.shape
    V = v.shape[-1]
    C = HGRN_CHUNK if L % HGRN_CHUNK == 0 else L
    n = L // C

    def to_chunks(a):
        return a.reshape(B, n, C, H, a.shape[-1]).transpose(1, 0, 3, 2, 4)

    tri = jnp.tril(jnp.ones((C, C), dtype=bool))[:, :, None]

    def step(S, inp):
        qc, kc, vc, lc = inp
        b = jnp.cumsum(lc, axis=2)
        o_inter = jnp.einsum('bhck,bhkv->bhcv', qc * jnp.exp(b), S)
        diff = b[:, :, :, None, :] - b[:, :, None, :, :]
        decay = jnp.exp(jnp.where(tri, diff, -jnp.inf))
        A = jnp.einsum('bhtk,bhsk,bhtsk->bhts', qc, kc, decay)
        o_intra = jnp.einsum('bhts,bhsv->bhtv', A, vc)
        b_last = b[:, :, -1:, :]
        S_new = jnp.exp(b_last[:, :, 0, :])[..., None] * S + jnp.einsum(
            'bhck,bhcv->bhkv', kc * jnp.exp(b_last - b), vc)
        return S_new, o_inter + o_intra

    S_fin, o = lax.scan(step, s0, (to_chunks(q), to_chunks(k), to_chunks(v), to_chunks(log_f)))
    o = o.transpose(1, 0, 3, 2, 4).reshape(B, L, H, V)
    return o, S_fin


def hgrn2_mix(xn, s0, w_in, lb, norm_w, w_o):
    B, L, _ = xn.shape
    q, f, i, g = jnp.split(xn @ w_in, 4, axis=-1)
    q = jax.nn.silu(q.astype(jnp.float32)) * (HGRN_KEY_DIM ** -0.5)
    forget = lb + (1.0 - lb) * jax.nn.sigmoid(f.astype(jnp.float32))
    k = 1.0 - forget
    log_f = jnp.log(forget)
    hk = lambda a: a.reshape(B, L, HGRN_HEADS, HGRN_KEY_DIM)
    o, s_fin = gla_chunked(hk(q), hk(k), i.astype(jnp.float32).reshape(B, L, HGRN_HEADS, HGRN_VAL_DIM),
                           hk(log_f), s0.astype(jnp.float32))
    o = o * lax.rsqrt(jnp.mean(o * o, axis=-1, keepdims=True) + RMS_EPS) * norm_w.astype(jnp.float32)
    o = o.reshape(B, L, D_MODEL) * jax.nn.silu(g.astype(jnp.float32))
    return o.astype(xn.dtype) @ w_o, s_fin


def swiglu(xn, w_in, w_out):
    gate, up = jnp.split(xn @ w_in, 2, axis=-1)
    return (jax.nn.silu(gate) * up) @ w_out


def setup_inputs(seed: int = 0) -> dict:
    key = jax.random.key(seed)
    ks = jax.random.split(key, 24)
    nrm = lambda k, shape, sc: jax.random.normal(k, shape, jnp.float32) * sc
    D = D_MODEL
    return {
        "x_prompt": nrm(ks[0], (BATCH, SEQ, D), 1.0),
        "x_sample": nrm(ks[1], (DEC_BATCH, DEC_SEQ, D), 1.0),
        "cache_k": nrm(ks[2], (N_ATTN_LAYERS, DEC_BATCH, WINDOW, N_KV_HEADS, ATTN_HEAD_DIM), 1.0),
        "cache_v": nrm(ks[3], (N_ATTN_LAYERS, DEC_BATCH, WINDOW, N_KV_HEADS, ATTN_HEAD_DIM), 1.0),
        "state_hgrn": nrm(ks[4], (N_HGRN_LAYERS, DEC_BATCH, HGRN_HEADS, HGRN_KEY_DIM, HGRN_VAL_DIM), 0.3),
        "norm_mix": 1.0 + nrm(ks[5], (DEPTH, D), 0.02),
        "norm_ffn": 1.0 + nrm(ks[6], (DEPTH, D), 0.02),
        "norm_final": 1.0 + nrm(ks[7], (D,), 0.02),
        "attn_w_qkv": nrm(ks[8], (N_ATTN_LAYERS, D, QKV_DIM), D ** -0.5),
        "attn_b_qkv": nrm(ks[9], (N_ATTN_LAYERS, QKV_DIM), 0.02),
        "attn_sinks": nrm(ks[10], (N_ATTN_LAYERS, N_Q_HEADS), 0.5),
        "attn_w_o": nrm(ks[11], (N_ATTN_LAYERS, Q_DIM, D), Q_DIM ** -0.5),
        "attn_b_o": nrm(ks[12], (N_ATTN_LAYERS, D), 0.02),
        "hgrn_w_in": nrm(ks[13], (N_HGRN_LAYERS, D, 4 * D), D ** -0.5),
        "hgrn_lower_bounds": nrm(ks[14], (DEPTH, D), 0.1),
        "hgrn_norm": 1.0 + nrm(ks[15], (N_HGRN_LAYERS, HGRN_VAL_DIM), 0.02),
        "hgrn_w_o": nrm(ks[16], (N_HGRN_LAYERS, D, D), D ** -0.5),
        "ffn_w_in": nrm(ks[17], (DEPTH, D, 2 * D_FF), D ** -0.5),
        "ffn_w_out": nrm(ks[18], (DEPTH, D_FF, D), D_FF ** -0.5),
    }


def reference(x_prompt, x_sample, cache_k, cache_v, state_hgrn,
              norm_mix, norm_ffn, norm_final,
              attn_w_qkv, attn_b_qkv, attn_sinks, attn_w_o, attn_b_o,
              hgrn_w_in, hgrn_lower_bounds, hgrn_norm, hgrn_w_o,
              ffn_w_in, ffn_w_out):
    p_lb = jax.nn.softmax(hgrn_lower_bounds.astype(jnp.float32), axis=0)
    lower_bounds = jnp.cumsum(p_lb, axis=0) - p_lb[0:1]

    hp, hs = x_prompt, x_sample
    wk_p, wv_p, st_p, wk_s, wv_s, st_s = [], [], [], [], [], []
    for i in range(DEPTH):
        xp_n = rmsnorm(hp, norm_mix[i])
        xs_n = rmsnorm(hs, norm_mix[i])
        if i % N_MIXERS == 0:
            a = i // N_MIXERS
            mp, kp, vp = swa_prompt(xp_n, attn_w_qkv[a], attn_b_qkv[a], attn_sinks[a], attn_w_o[a], attn_b_o[a])
            ms, ks_, vs_ = swa_sample(xs_n, cache_k[a], cache_v[a], attn_w_qkv[a], attn_b_qkv[a],
                                      attn_sinks[a], attn_w_o[a], attn_b_o[a])
            wk_p.append(kp.astype(cache_k.dtype)); wv_p.append(vp.astype(cache_v.dtype))
            wk_s.append(ks_.astype(cache_k.dtype)); wv_s.append(vs_.astype(cache_v.dtype))
        else:
            r = i // N_MIXERS
            s0_p = jnp.zeros((hp.shape[0], HGRN_HEADS, HGRN_KEY_DIM, HGRN_VAL_DIM), jnp.float32)
            mp, sp = hgrn2_mix(xp_n, s0_p, hgrn_w_in[r], lower_bounds[i], hgrn_norm[r], hgrn_w_o[r])
            ms, ss = hgrn2_mix(xs_n, state_hgrn[r], hgrn_w_in[r], lower_bounds[i], hgrn_norm[r], hgrn_w_o[r])
            st_p.append(sp.astype(state_hgrn.dtype)); st_s.append(ss.astype(state_hgrn.dtype))
        hp = hp + mp
        hs = hs + ms
        hp = hp + swiglu(rmsnorm(hp, norm_ffn[i]), ffn_w_in[i], ffn_w_out[i])
        hs = hs + swiglu(rmsnorm(hs, norm_ffn[i]), ffn_w_in[i], ffn_w_out[i])

    y_prompt = rmsnorm(hp, norm_final)
    y_sample = rmsnorm(hs, norm_final)
    win_k_prompt = jnp.stack(wk_p)
    win_v_prompt = jnp.stack(wv_p)
    state_prompt = jnp.stack(st_p)
    win_k_sample = jnp.stack(wk_s)
    win_v_sample = jnp.stack(wv_s)
    state_sample = jnp.stack(st_s)
    return (y_prompt, y_sample, win_k_prompt, win_v_prompt, state_prompt, win_k_sample, win_v_sample, state_sample)
```

```cpp
#include <hip/hip_runtime.h>
#include <cstdio>
#include <cstdint>
namespace pg8 {
#define PG8_LAS __attribute__((address_space(3)))
typedef unsigned short bf16_t;
typedef short bf16x8 __attribute__((ext_vector_type(8)));
typedef float f32x4 __attribute__((ext_vector_type(4)));
typedef unsigned u32x4 __attribute__((ext_vector_type(4)));
constexpr int BM = 256, BK = 64, HALF = 128, HTB = HALF * BK * 2  , STAGE_BYTES = 8 * HTB, NXCD = 8, WGM = 8;

__host__ __device__ __forceinline__ int lds_byte(int r, int c) { const int st = (r >> 4) * 2 + (c >> 5), rr = r & 15, cc = c & 31, ob = rr * 64 + cc * 2; return st * 1024 + (ob ^ (((ob >> 9) & 1) << 5)); }
__host__ __device__ __forceinline__ void stage_rc(int b, int& R, int& C) { const int st = b / 1024, sb = b % 1024, swz = sb ^ (((sb >> 9) & 1) << 5); R = (st >> 1) * 16 + swz / 64; C = (st & 1) * 32 + (swz % 64) / 2; }
__host__ __device__ __forceinline__ int perm32(int rho) { const int n = rho >> 4, i = rho & 15; return 8 * (i >> 2) + 4 * n + (i & 3); }

struct Unit { int pm, pn; };
struct Gemm { const bf16_t* A; const bf16_t* Bt; int M, N, K; };

struct StaticOrder {
    int nM, nN, nwg, G, c, nx;
    __host__ __device__ void init(int M, int N, int G_, int c_, int nx_ = NXCD) { nM = M / BM; nN = N / BM; nwg = nM * nN; G = G_; c = c_; nx = nx_; }
    __host__ __device__ bool next(int i, Unit& u) const {
        const long L = (long)i * G + c; if (L >= nwg) return false;
        int wgid = (int)L; { const int q = nwg / nx, r = nwg % nx, xcd = wgid % nx, off = wgid / nx; wgid = (xcd < r ? xcd * (q + 1) : r * (q + 1) + (xcd - r) * q) + off; }
        const int nig = WGM * nN, gid = wgid / nig, fm = gid * WGM, gsz = (nM - fm) < WGM ? (nM - fm) : WGM;
        u.pm = fm + ((wgid % nig) % gsz); u.pn = (wgid % nig) / gsz; return true;
    }
    __device__ __forceinline__ void a_ready(const Unit&) const {}
    __device__ __forceinline__ void done(const Unit&) const {}
};
__device__ __forceinline__ unsigned cvt_pk_bf16(float lo, float hi) { unsigned r; asm volatile("v_cvt_pk_bf16_f32 %0, %1, %2" : "=v"(r) : "v"(lo), "v"(hi)); return r; }
typedef int i32x4 __attribute__((ext_vector_type(4)));
template <bool I8> __device__ __forceinline__ f32x4 mma16(bf16x8 b, bf16x8 a, f32x4 c) {
    if constexpr (I8) return __builtin_bit_cast(f32x4, __builtin_amdgcn_mfma_i32_16x16x64_i8(__builtin_bit_cast(i32x4, b), __builtin_bit_cast(i32x4, a), __builtin_bit_cast(i32x4, c), 0, 0, 0));
    else return __builtin_amdgcn_mfma_f32_16x16x32_bf16(b, a, c, 0, 0, 0);
}
template <class Epi, class Sched, bool ALIGN_EPI = false, bool SP2 = false, bool I8 = false>
__device__ __forceinline__ void gemm_phase(PG8_LAS unsigned char* lds, const Gemm g, const Sched& S, const Epi& E) {
    const int tid = threadIdx.x, wid = __builtin_amdgcn_readfirstlane(tid >> 6), lane = tid & 63, wr = wid >> 2, wc = wid & 3, fr = lane & 15, fq = lane >> 4;
    const int K = g.K, nt = K / BK;
    unsigned voffA[2], voffB[2];
#pragma unroll
    for (int i = 0; i < 2; ++i) { int R, C; stage_rc(tid * 16 + i * 8192, R, C); const int Rb = Epi::PERM ? ((R & ~31) + perm32(R & 31)) : R;
        voffA[i] = (unsigned)(R * K + C) * 2u; voffB[i] = (unsigned)(Rb * K + C) * 2u; }
    const size_t kstep = (size_t)(BK * 2);
    const size_t hstep = (size_t)HALF * K * 2;
    const size_t tstep = 2 * hstep;
    const unsigned ldsw = (unsigned)wid * 1024u;
    const int aoff = lds_byte(wr * 64 + fr, fq * 8), boff = lds_byte(wc * 32 + fr, fq * 8);
#define PG8_SA(b, h) (((b) * 2 + (h)) * HTB)
#define PG8_SB(b, h) ((4 + (b) * 2 + (h)) * HTB)
#define PG8_STAGE(bufoff, gbase, voff) do { _Pragma("unroll") for (int _i = 0; _i < 2; ++_i) \
        __builtin_amdgcn_global_load_lds((const unsigned*)((const char*)(gbase) + (voff)[_i]), (PG8_LAS unsigned*)(lds + (bufoff) + ldsw + _i * 8192), 16, 0, 0); } while (0)
#define PG8_LDA(dst, b, h) do { _Pragma("unroll") for (int m = 0; m < 4; ++m) _Pragma("unroll") for (int k = 0; k < 2; ++k) dst[m][k] = *(const PG8_LAS bf16x8*)(lds + PG8_SA(b, h) + aoff + m * 2048 + k * 1024); } while (0)
#define PG8_LDB(dst, b, h) do { _Pragma("unroll") for (int n = 0; n < 2; ++n) _Pragma("unroll") for (int k = 0; k < 2; ++k) dst[n][k] = *(const PG8_LAS bf16x8*)(lds + PG8_SB(b, h) + boff + n * 2048 + k * 1024); } while (0)
#define PG8_MMA(ai, bj, At, Bt) do { __builtin_amdgcn_s_setprio(1); _Pragma("unroll") for (int m = 0; m < 4; ++m) _Pragma("unroll") for (int n = 0; n < 2; ++n) _Pragma("unroll") for (int k = 0; k < 2; ++k) \
        acc[ai][bj][m][n] = mma16<I8>(Bt[n][k], At[m][k], acc[ai][bj][m][n]); __builtin_amdgcn_s_setprio(0); } while (0)
#define PG8_WAIT_V(n) asm volatile("s_waitcnt vmcnt(" #n ")" ::: "memory")
#define PG8_WAIT_L(n) asm volatile("s_waitcnt lgkmcnt(" #n ")" ::: "memory")
#define PG8_BAR __builtin_amdgcn_s_barrier()
#define PG8_SCHED __builtin_amdgcn_sched_barrier(0)
    Unit cur, nxt; int ui = 0;
    if (!S.next(0, cur)) return;
    f32x4 acc[2][2][4][2];
#pragma unroll
    for (int a = 0; a < 2; ++a)
#pragma unroll
        for (int b = 0; b < 2; ++b)
#pragma unroll
            for (int m = 0; m < 4; ++m)
#pragma unroll
                for (int n = 0; n < 2; ++n) acc[a][b][m][n] = (f32x4){0.f, 0.f, 0.f, 0.f};
    bf16x8 At[4][2], B0[2][2], B1[2][2];
    const char* cA = (const char*)g.A + (size_t)cur.pm * tstep; const char* cB = (const char*)g.Bt + (size_t)cur.pn * tstep;
    S.a_ready(cur);
    if constexpr (SP2) {
        PG8_STAGE(PG8_SB(0, 0), cB, voffB); PG8_STAGE(PG8_SB(0, 1), cB + hstep, voffB); PG8_STAGE(PG8_SA(0, 0), cA, voffA); PG8_STAGE(PG8_SA(0, 1), cA + hstep, voffA);
        if (wr == 1) PG8_BAR;
        PG8_WAIT_V(2); PG8_BAR;
        PG8_STAGE(PG8_SB(1, 0), cB + kstep, voffB); PG8_STAGE(PG8_SA(1, 0), cA + kstep, voffA); PG8_STAGE(PG8_SB(1, 1), cB + hstep + kstep, voffB);
        PG8_WAIT_V(6); PG8_BAR;
    } else {
        PG8_STAGE(PG8_SB(0, 0), cB, voffB); PG8_STAGE(PG8_SA(0, 0), cA, voffA); PG8_STAGE(PG8_SB(0, 1), cB + hstep, voffB); PG8_STAGE(PG8_SA(0, 1), cA + hstep, voffA);
        if (wr == 1) PG8_BAR;
        PG8_WAIT_V(4); PG8_BAR;
        PG8_STAGE(PG8_SB(1, 0), cB + kstep, voffB); PG8_STAGE(PG8_SA(1, 0), cA + kstep, voffA); PG8_STAGE(PG8_SB(1, 1), cB + hstep + kstep, voffB);
        PG8_WAIT_V(6); PG8_BAR;
    }
    for (;;) {
        const bool has_next = S.next(ui + 1, nxt);
        const char* nA = has_next ? (const char*)g.A + (size_t)nxt.pm * tstep : cA; const char* nB = has_next ? (const char*)g.Bt + (size_t)nxt.pn * tstep : cB;
        for (int t = 0; t < nt; t += 2) {
            const bool last = (t == nt - 2);
            const char* a1 = cA + (size_t)(t + 1) * kstep;
            const char* a2 = last ? nA : cA + (size_t)(t + 2) * kstep; const char* b2 = last ? nB : cB + (size_t)(t + 2) * kstep;
            const char* a3 = a2 + kstep; const char* b3 = b2 + kstep;
            if (last && has_next) S.a_ready(nxt);
            if constexpr (SP2) {
            PG8_LDB(B0, 0, 0); PG8_LDB(B1, 0, 1); PG8_SCHED; PG8_LDA(At, 0, 0); PG8_STAGE(PG8_SA(1, 1), a1 + hstep, voffA);
            PG8_WAIT_V(8); PG8_WAIT_L(0); PG8_BAR; PG8_MMA(0, 0, At, B0); PG8_MMA(0, 1, At, B1); PG8_BAR; PG8_SCHED;
            PG8_LDA(At, 0, 1); PG8_STAGE(PG8_SB(0, 0), b2, voffB); PG8_STAGE(PG8_SB(0, 1), b2 + hstep, voffB); PG8_STAGE(PG8_SA(0, 0), a2, voffA);
            PG8_WAIT_V(8); PG8_WAIT_L(0); PG8_BAR; PG8_MMA(1, 0, At, B0); PG8_MMA(1, 1, At, B1); PG8_BAR; PG8_SCHED;
            PG8_LDB(B0, 1, 0); PG8_LDB(B1, 1, 1); PG8_SCHED; PG8_LDA(At, 1, 0); PG8_STAGE(PG8_SA(0, 1), a2 + hstep, voffA);
            PG8_WAIT_V(8); PG8_WAIT_L(0); PG8_BAR; PG8_MMA(0, 0, At, B0); PG8_MMA(0, 1, At, B1); PG8_BAR; PG8_SCHED;
            PG8_LDA(At, 1, 1); PG8_STAGE(PG8_SB(1, 0), b3, voffB); PG8_STAGE(PG8_SB(1, 1), b3 + hstep, voffB); PG8_STAGE(PG8_SA(1, 0), a3, voffA);
            PG8_WAIT_V(8); PG8_WAIT_L(0); PG8_BAR; PG8_MMA(1, 0, At, B0); PG8_MMA(1, 1, At, B1); PG8_BAR; PG8_SCHED;
            } else {
            PG8_LDB(B0, 0, 0); PG8_SCHED; PG8_LDA(At, 0, 0); PG8_STAGE(PG8_SA(1, 1), a1 + hstep, voffA);
            PG8_WAIT_L(8); PG8_BAR; PG8_WAIT_L(0); PG8_MMA(0, 0, At, B0); PG8_BAR; PG8_SCHED;
            PG8_LDB(B1, 0, 1); PG8_STAGE(PG8_SB(0, 0), b2, voffB);
            PG8_BAR; PG8_WAIT_L(0); PG8_MMA(0, 1, At, B1); PG8_BAR;
            PG8_LDA(At, 0, 1); PG8_STAGE(PG8_SA(0, 0), a2, voffA);
            PG8_BAR; PG8_WAIT_L(0); PG8_MMA(1, 0, At, B0); PG8_BAR; PG8_SCHED;
            PG8_STAGE(PG8_SB(0, 1), b2 + hstep, voffB);
            PG8_WAIT_V(6); PG8_BAR; PG8_MMA(1, 1, At, B1); PG8_BAR;
            PG8_LDB(B0, 1, 0); PG8_SCHED; PG8_LDA(At, 1, 0); PG8_STAGE(PG8_SA(0, 1), a2 + hstep, voffA);
            PG8_WAIT_L(8); PG8_BAR; PG8_WAIT_L(0); PG8_MMA(0, 0, At, B0); PG8_BAR; PG8_SCHED;
            PG8_LDB(B1, 1, 1); PG8_STAGE(PG8_SB(1, 0), b3, voffB);
            PG8_BAR; PG8_WAIT_L(0); PG8_MMA(0, 1, At, B1); PG8_BAR;
            PG8_LDA(At, 1, 1); PG8_STAGE(PG8_SA(1, 0), a3, voffA);
            PG8_BAR; PG8_WAIT_L(0); PG8_MMA(1, 0, At, B0); PG8_BAR; PG8_SCHED;
            PG8_STAGE(PG8_SB(1, 1), b3 + hstep, voffB);
            PG8_WAIT_V(6); PG8_BAR; PG8_MMA(1, 1, At, B1); PG8_BAR;
            }
        }
        if constexpr (ALIGN_EPI) { if (wr == 0) PG8_BAR; }
        if constexpr (!Epi::AFTER_DRAIN) { E(acc, cur, wr, wc, fr, fq); S.done(cur); }
        if (!has_next) break;
#pragma unroll
        for (int a = 0; a < 2; ++a)
#pragma unroll
            for (int b = 0; b < 2; ++b)
#pragma unroll
                for (int m = 0; m < 4; ++m)
#pragma unroll
                    for (int n = 0; n < 2; ++n) acc[a][b][m][n] = (f32x4){0.f, 0.f, 0.f, 0.f};
        cur = nxt; cA = nA; cB = nB; ++ui;
        if constexpr (ALIGN_EPI) { if (wr == 1) PG8_BAR; }
    }
    PG8_WAIT_V(0);
    if constexpr (!ALIGN_EPI) { if (wr == 0) PG8_BAR; }
    PG8_BAR;
    if constexpr (Epi::AFTER_DRAIN) { E.fused(acc, cur, wr, wc, fr, fq, lds, wid, lane); S.done(cur); }
#undef PG8_SA
#undef PG8_SB
#undef PG8_STAGE
#undef PG8_LDA
#undef PG8_LDB
#undef PG8_MMA
#undef PG8_WAIT_V
#undef PG8_WAIT_L
#undef PG8_BAR
#undef PG8_SCHED
}
}

#ifndef MK_N_LAUNCHES
#define MK_N_LAUNCHES 1
#endif
constexpr int NPHASE = 12;
constexpr int N_LAUNCHES = MK_N_LAUNCHES;
constexpr int NWAVES = 8;

constexpr int D = 4096, MP = 8192, MS = 32, MT = MP + MS, SEQ = 2048, NBATCH = 4, QKVN = 5120, KVD = 512, DFF = 11008, NFI = 2 * DFF, NHG = 4 * D;
constexpr float RMS_EPS = 1e-5f;
constexpr float LOG2E = 1.4426950408889634f;
constexpr size_t OUT_Y = 0, OUT_WKP = (size_t)MT * D, OUT_WVP = OUT_WKP + 262144, OUT_STP = OUT_WVP + 262144, OUT_WKS = OUT_STP + 2097152, OUT_WVS = OUT_WKS + 2097152, OUT_STS = OUT_WVS + 2097152, OUT_END = OUT_STS + 16777216;

constexpr size_t MiB = 1u << 20;
constexpr size_t WS_CTL = 0, CTL_ZERO_BYTES = 1 * MiB;
constexpr size_t WS_LB = 1 * MiB;
constexpr size_t WS_WQKV = 2 * MiB, WS_WO = 42 * MiB, WS_WFI0 = 74 * MiB, WS_WFO0 = 246 * MiB, WS_WHI = 332 * MiB, WS_WHO = 460 * MiB, WS_WFI1 = 492 * MiB, WS_WFO1 = 664 * MiB;
constexpr size_t WS_XN = 750 * MiB, WS_X = 815 * MiB, WS_Q = 944 * MiB, WS_K = 1009 * MiB, WS_V = 1018 * MiB, WS_O = 1027 * MiB, WS_H = 1092 * MiB;
constexpr size_t WS_QT = 1265 * MiB, WS_KT = 1330 * MiB, WS_KP = 1395 * MiB, WS_VI = 1460 * MiB, WS_GS = 1525 * MiB, WS_DEC = 1590 * MiB, WS_SRAW = 1592 * MiB, WS_END = 1594 * MiB;
constexpr size_t WS_XQ = 815 * MiB, WS_RA = 847 * MiB, WS_WQ1 = 848 * MiB, WS_BSC = 935 * MiB;
constexpr size_t WS_WQ0 = 1265 * MiB, WS_BSC0 = 1395 * MiB, WS_WQO = 1396 * MiB, WS_BSCO = 1412 * MiB, WS_WQQ = 1413 * MiB, WS_BSCQ = 1433 * MiB;
static_assert(WS_RA - WS_XQ >= (size_t)MP * D && WS_BSC - WS_WQ1 >= (size_t)NFI * D && WS_Q - WS_BSC >= (size_t)NFI * 4, "ws map (int8)");
static_assert(WS_WO - WS_WQKV >= (size_t)QKVN * D * 2 && WS_WFO0 - WS_WFI0 >= (size_t)NFI * D * 2 && WS_WHI - WS_WFO0 >= (size_t)D * DFF * 2 && WS_WHO - WS_WHI >= (size_t)NHG * D * 2, "ws map (weights)");
static_assert(WS_X - WS_XN >= (size_t)MT * D * 2 && WS_Q - WS_X >= (size_t)MT * D * 4 && WS_K - WS_Q >= (size_t)MT * D * 2 && WS_V - WS_K >= (size_t)MT * KVD * 2 && WS_QT - WS_H >= (size_t)MT * DFF * 2, "ws map (activations)");
constexpr int CW_TMO = 0, CW_CODE = 1, CW_BAR = 4096, CW_SS = 16384, SS_STRIDE = 8448;
static_assert(CW_SS * 4 + 5 * SS_STRIDE * 8 <= (int)CTL_ZERO_BYTES, "CTL words inside the memset region");
constexpr int CW_SRES = 8384;
constexpr size_t WS_PART = 936 * MiB;
constexpr int CW_SIDE_A = 8192, CW_SIDE_B = 8256, CW_FLAG_WO = 8320;

constexpr int RING_OFF = 0, RING_BYTES = 131072;
constexpr int LDSCTL_OFF = RING_BYTES, MISC_OFF = LDSCTL_OFF + 320;
constexpr int LDS_BYTES = 147456;
constexpr int PTAB_OFF = LDSCTL_OFF + 1024;

#define GAS __attribute__((address_space(1)))
#define LAS __attribute__((address_space(3)))
typedef unsigned short bf16;
typedef unsigned v4u __attribute__((ext_vector_type(4)));
typedef unsigned v2u __attribute__((ext_vector_type(2)));
typedef float f32x4 __attribute__((ext_vector_type(4)));
typedef float f32x16 __attribute__((ext_vector_type(16)));
typedef short bf16x8 __attribute__((ext_vector_type(8)));
typedef short s16x4 __attribute__((ext_vector_type(4)));
typedef GAS unsigned gu32;
#define RLX_AGENT __ATOMIC_RELAXED, __HIP_MEMORY_SCOPE_AGENT
#define LDS_WAIT() asm volatile("s_waitcnt lgkmcnt(0)" ::: "memory")
#define VM_WAIT() asm volatile("s_waitcnt vmcnt(0)" ::: "memory")
#define MFMA32(a, b, c) __builtin_amdgcn_mfma_f32_32x32x16_bf16((a), (b), (c), 0, 0, 0)
#define MFMA16(a, b, c) __builtin_amdgcn_mfma_f32_16x16x32_bf16((a), (b), (c), 0, 0, 0)
typedef __bf16 bf16x2_t __attribute__((ext_vector_type(2)));
typedef float f32x2_t __attribute__((ext_vector_type(2)));
__device__ __forceinline__ unsigned pk2(float lo, float hi) { f32x2_t v = {lo, hi}; bf16x2_t b = __builtin_convertvector(v, bf16x2_t); return __builtin_bit_cast(unsigned, b); }
__device__ __forceinline__ float bf2f(bf16 b) { return __builtin_bit_cast(float, (unsigned)b << 16); }
__device__ __forceinline__ float fast_exp2(float x) { return __builtin_amdgcn_exp2f(x); }
__device__ __forceinline__ float fast_rcp(float x) { return __builtin_amdgcn_rcpf(x); }
__device__ __forceinline__ float sigmoidf_(float x) { return fast_rcp(1.0f + fast_exp2(-x * LOG2E)); }
__device__ __forceinline__ float siluf_(float x) { return x * sigmoidf_(x); }
__device__ __forceinline__ int crow(int reg, int h) { return (reg & 3) + 8 * (reg >> 2) + 4 * h; }
typedef short v4i16_t __attribute__((ext_vector_type(4)));
__device__ __forceinline__ s16x4 tr_read(const LAS unsigned char* p) { return __builtin_bit_cast(s16x4, __builtin_amdgcn_ds_read_tr16_b64_v4i16((LAS v4i16_t*)p)); }
__device__ __forceinline__ bf16x8 tr_frag(const LAS unsigned char* p_lo, const LAS unsigned char* p_hi) { const s16x4 lo = tr_read(p_lo), hi = tr_read(p_hi); return __builtin_shufflevector(lo, hi, 0, 1, 2, 3, 4, 5, 6, 7); }
typedef unsigned long long ssq_t;
__device__ __forceinline__ ssq_t ss_fix(float sq) { return (ssq_t)(sq * 16777216.0f + 0.5f); }
__device__ __forceinline__ float ss_rstd(const ssq_t* ss, int r) { return __builtin_amdgcn_rsqf((float)ss[r] * (1.0f / (16777216.0f * D)) + RMS_EPS); }
__device__ __forceinline__ float wave_sum(float v) {
#pragma unroll
    for (int o = 1; o < 64; o <<= 1) v += __shfl_xor(v, o);
    return v;
}
__device__ __forceinline__ float wave_max(float v) {
#pragma unroll
    for (int o = 1; o < 64; o <<= 1) v = fmaxf(v, __shfl_xor(v, o));
    return v;
}
#define XB_TMO      128
#define XB_XCNT(j)  (256  + 64 * (j))
#define XB_XSUB(j)  (1280 + 64 * (j))
#define XB_XGEN(j)  (2304 + 64 * (j))
#define XB_TOP      3328
#define XB_TOPGEN   3392
#define XCD_BAR_WORDS 3456
#define XB_SPIN_CAP (1u << 18)

__device__ __forceinline__ unsigned xb_ld(unsigned* p)              { return __hip_atomic_load(p, __ATOMIC_RELAXED, __HIP_MEMORY_SCOPE_AGENT); }
__device__ __forceinline__ unsigned xb_add(unsigned* p, unsigned v) { return __hip_atomic_fetch_add(p, v, __ATOMIC_RELAXED, __HIP_MEMORY_SCOPE_AGENT); }
__device__ __forceinline__ unsigned xb_xcc_id() { return (unsigned)__builtin_amdgcn_s_getreg((3 << 11) | 20) & 0xFu; }
#define XB_SPIN(cond, bar) do { unsigned _sp = 0; while (cond) { __builtin_amdgcn_s_sleep(1); \
    if ((++_sp & 255u) == 0u) { if (xb_ld(&(bar)[XB_TMO])) break; if (_sp > XB_SPIN_CAP) { atomicAdd(&(bar)[XB_TMO], 1u); break; } } } } while (0)

struct XcdBarrier {
    unsigned* bar; unsigned x;
    volatile LAS unsigned* st;
};

__device__ __forceinline__ XcdBarrier xcd_barrier_post(unsigned* bar, volatile LAS unsigned* st) {
    XcdBarrier b; b.bar = bar; b.x = xb_xcc_id(); b.st = st;
    if (threadIdx.x == 0) (void)xb_add(&bar[XB_XCNT(b.x)], 1u);
    return b;
}
__device__ __forceinline__ void xcd_barrier_complete(unsigned* bar, unsigned x, unsigned& nloc, unsigned& nx) {
    const unsigned G = gridDim.x * gridDim.y * gridDim.z;
    unsigned sum, cnt, mine, sp = 0u;
    for (;;) {
        sum = 0u; cnt = 0u; mine = 0u;
#pragma unroll
        for (unsigned j = 0; j < 16; ++j) { const unsigned c = xb_ld(&bar[XB_XCNT(j)]); sum += c; cnt += (c > 0u) ? 1u : 0u; mine = (j == x) ? c : mine; }
        if (sum == G) break;
        __builtin_amdgcn_s_sleep(1);
        if ((++sp & 255u) == 0u) { if (xb_ld(&bar[XB_TMO])) break; if (sp > XB_SPIN_CAP) { atomicAdd(&bar[XB_TMO], 1u); break; } }
    }
    nloc = mine > 0u ? mine : 1u; nx = cnt > 0u ? cnt : 1u;
}

__device__ __forceinline__ void xcd_barrier(const XcdBarrier& b) {
    asm volatile("s_waitcnt vmcnt(0)" ::: "memory");
    __syncthreads();
    if (threadIdx.x == 0) {
        unsigned* bar = b.bar;
        __builtin_amdgcn_s_waitcnt(0);
        unsigned nloc = b.st[0], nx = b.st[1];
        if (nloc == 0u) { xcd_barrier_complete(bar, b.x, nloc, nx); b.st[0] = nloc; b.st[1] = nx; }
        const unsigned old = xb_add(&bar[XB_XSUB(b.x)], 1u);
        const unsigned gen = old / nloc;
        if (old + 1u == (gen + 1u) * nloc) {
            __builtin_amdgcn_fence(__ATOMIC_RELEASE, "agent");
            asm volatile("s_waitcnt vmcnt(0)" ::: "memory");
            const unsigned og = xb_add(&bar[XB_TOP], 1u);
            const unsigned tg = og / nx;
            if (og + 1u == (tg + 1u) * nx) xb_add(&bar[XB_TOPGEN], 1u);
            else XB_SPIN(xb_ld(&bar[XB_TOPGEN]) == tg, bar);
            __builtin_amdgcn_fence(__ATOMIC_ACQUIRE, "agent");
            xb_add(&bar[XB_XGEN(b.x)], 1u);
            asm volatile("s_waitcnt vmcnt(0)" ::: "memory");
        } else {
            XB_SPIN(xb_ld(&bar[XB_XGEN(b.x)]) == gen, bar);
            __builtin_amdgcn_fence(__ATOMIC_ACQUIRE, "agent");
            asm volatile("s_waitcnt vmcnt(0)" ::: "memory");
        }
    }
    __syncthreads();
}

__device__ __forceinline__ void side_barrier(unsigned* ctr, unsigned target, unsigned* tmo) {
    asm volatile("s_waitcnt vmcnt(0)" ::: "memory");
    __syncthreads();
    if (threadIdx.x == 0) {
        __builtin_amdgcn_fence(__ATOMIC_RELEASE, "agent");
        asm volatile("s_waitcnt vmcnt(0)" ::: "memory");
        (void)xb_add(ctr, 1u);
        XB_SPIN(xb_ld(ctr) < target, tmo - XB_TMO);
        __builtin_amdgcn_fence(__ATOMIC_ACQUIRE, "agent");
        asm volatile("s_waitcnt vmcnt(0)" ::: "memory");
    }
    __syncthreads();
}

typedef pg8::Unit Unit;
template <bool Q8> struct EpiQKVT {
    static constexpr bool PERM = true, AFTER_DRAIN = false;
    bf16 *Q, *K, *V; const float* bias; float *wk, *wv; const ssq_t* ss; const float* ra; const float* bs; int pn0;
    __device__ __forceinline__ void operator()(const f32x4 (&acc)[2][2][4][2], const Unit& u, int wr, int wc, int fr, int fq) const {
        const int pn = u.pn + pn0; const int row0 = u.pm * 256 + wr * 64 + fr, colt = pn * 256;
        bf16* base; int ldc, cc; float* win = nullptr;
        if (pn < 16) { base = Q; ldc = D; cc = colt; } else if (pn < 18) { base = K; ldc = KVD; cc = colt - D; win = wk; } else { base = V; ldc = KVD; cc = colt - D - KVD; win = wv; }
        const int col0 = cc + wc * 32 + 8 * fq, bcol0 = colt + wc * 32 + 8 * fq;
        f32x4 bv[2][2];
#pragma unroll
        for (int bj = 0; bj < 2; ++bj)
#pragma unroll
            for (int n = 0; n < 2; ++n) bv[bj][n] = *(const f32x4*)(bias + bcol0 + bj * 128 + 4 * n);
        const bool dowin = (win != nullptr) && ((u.pm & 7) == 7);
        float rsv[2][4];
#pragma unroll
        for (int ai = 0; ai < 2; ++ai)
#pragma unroll
            for (int m = 0; m < 4; ++m) rsv[ai][m] = Q8 ? ra[row0 + ai * 128 + m * 16] : ss_rstd(ss, row0 + ai * 128 + m * 16);
        f32x4 bsv[2][2];
        if constexpr (Q8) {
#pragma unroll
            for (int bj = 0; bj < 2; ++bj)
#pragma unroll
                for (int n = 0; n < 2; ++n) bsv[bj][n] = *(const f32x4*)(bs + bcol0 + bj * 128 + 4 * n);
        }
#pragma unroll
        for (int ai = 0; ai < 2; ++ai)
#pragma unroll
            for (int m = 0; m < 4; ++m) { const int r = row0 + ai * 128 + m * 16; bf16* rowp = base + (size_t)r * ldc + col0; const float rs = rsv[ai][m];
#pragma unroll
                for (int bj = 0; bj < 2; ++bj) { f32x4 v0, v1;
                    if constexpr (Q8) { const pg8::i32x4 i0 = __builtin_bit_cast(pg8::i32x4, acc[ai][bj][m][0]), i1 = __builtin_bit_cast(pg8::i32x4, acc[ai][bj][m][1]);
#pragma unroll
                        for (int j = 0; j < 4; ++j) { v0[j] = (float)i0[j] * (rs * bsv[bj][0][j]) + bv[bj][0][j]; v1[j] = (float)i1[j] * (rs * bsv[bj][1][j]) + bv[bj][1][j]; } }
                    else { v0 = acc[ai][bj][m][0] * rs + bv[bj][0]; v1 = acc[ai][bj][m][1] * rs + bv[bj][1]; }
                    v4u w; w.x = pk2(v0[0], v0[1]); w.y = pk2(v0[2], v0[3]); w.z = pk2(v1[0], v1[1]); w.w = pk2(v1[2], v1[3]);
                    *(v4u*)(rowp + bj * 128) = w;
                    if (ai == 1 && dowin) { float* wp = win + ((size_t)((u.pm >> 3) * 128 + wr * 64 + m * 16 + fr) * KVD + col0 + bj * 128); *(f32x4*)wp = v0; *(f32x4*)(wp + 4) = v1; } } }
    }
};
typedef EpiQKVT<false> EpiQKV;
template <bool Q8> struct EpiResT {
    static constexpr bool PERM = true, AFTER_DRAIN = false;
    bf16* xb; float* out; const float* bias; ssq_t* ss; const float* ra; const float* bs;
    __device__ __forceinline__ void operator()(const f32x4 (&acc)[2][2][4][2], const Unit& u, int wr, int wc, int fr, int fq) const {
        const int row0 = u.pm * 256 + wr * 64 + fr, col0 = u.pn * 256 + wc * 32 + 8 * fq;
        f32x4 bv[2][2], bsv[2][2]; float rsv[2][4];
        if constexpr (Q8) {
#pragma unroll
            for (int bj = 0; bj < 2; ++bj)
#pragma unroll
                for (int n = 0; n < 2; ++n) bsv[bj][n] = *(const f32x4*)(bs + col0 + bj * 128 + 4 * n);
#pragma unroll
            for (int ai = 0; ai < 2; ++ai)
#pragma unroll
                for (int m = 0; m < 4; ++m) rsv[ai][m] = ra[row0 + ai * 128 + m * 16];
        }
#pragma unroll
        for (int bj = 0; bj < 2; ++bj)
#pragma unroll
            for (int n = 0; n < 2; ++n) bv[bj][n] = bias ? *(const f32x4*)(bias + col0 + bj * 128 + 4 * n) : (f32x4){0.f, 0.f, 0.f, 0.f};
#pragma unroll
        for (int ai = 0; ai < 2; ++ai) {
          v4u xra[2][4][2];
          if (!Q8 || true) {
#pragma unroll
            for (int m = 0; m < 4; ++m)
#pragma unroll
                for (int bj = 0; bj < 2; ++bj) xra[ai][m][bj] = *(const v4u*)(xb + (unsigned)(row0 + ai * 128 + m * 16) * D + col0 + bj * 128);
          }
#pragma unroll
            for (int m = 0; m < 4; ++m) { const int r = row0 + ai * 128 + m * 16; const unsigned off = (unsigned)r * D + col0; float sq = 0.f;
#pragma unroll
                for (int bj = 0; bj < 2; ++bj) { const v4u xr1 = xra[ai][m][bj]; const unsigned xw_[4] = {xr1.x, xr1.y, xr1.z, xr1.w}; float o[8];
                    f32x4 av[2] = {acc[ai][bj][m][0], acc[ai][bj][m][1]};
                    if constexpr (Q8) {
#pragma unroll
                        for (int n = 0; n < 2; ++n) { const pg8::i32x4 iv = __builtin_bit_cast(pg8::i32x4, acc[ai][bj][m][n]);
#pragma unroll
                            for (int j = 0; j < 4; ++j) av[n][j] = (float)iv[j] * (rsv[ai][m] * bsv[bj][n][j]); } }
#pragma unroll
                    for (int e = 0; e < 8; ++e) { const float xv = __builtin_bit_cast(float, (e & 1) ? (xw_[e >> 1] & 0xffff0000u) : (xw_[e >> 1] << 16)); o[e] = xv + av[e >> 2][e & 3] + bv[bj][e >> 2][e & 3]; }
                    if (out) { *(f32x4*)(out + off + bj * 128) = (f32x4){o[0], o[1], o[2], o[3]}; *(f32x4*)(out + off + bj * 128 + 4) = (f32x4){o[4], o[5], o[6], o[7]};
#pragma unroll
                        for (int e = 0; e < 8; ++e) sq += o[e] * o[e]; }
                    else { v4u w; w.x = pk2(o[0], o[1]); w.y = pk2(o[2], o[3]); w.z = pk2(o[4], o[5]); w.w = pk2(o[6], o[7]); *(v4u*)(xb + off + bj * 128) = w;
                        const unsigned ww_[4] = {w.x, w.y, w.z, w.w};
#pragma unroll
                        for (int e = 0; e < 8; ++e) { const float xv = __builtin_bit_cast(float, (e & 1) ? (ww_[e >> 1] & 0xffff0000u) : (ww_[e >> 1] << 16)); sq += xv * xv; } } }
                sq += __shfl_xor(sq, 16); sq += __shfl_xor(sq, 32);
                if (fq == 0) __hip_atomic_fetch_add(ss + r, ss_fix(sq), RLX_AGENT);
                asm volatile("" ::: "memory"); }
        }
    }
};
typedef EpiResT<false> EpiRes;
struct EpiSwiGLU {
    static constexpr bool PERM = true, AFTER_DRAIN = false;
    bf16* H; const ssq_t* ss;
    __device__ __forceinline__ void operator()(const f32x4 (&acc)[2][2][4][2], const Unit& u, int wr, int wc, int fr, int fq) const {
        const int row0 = u.pm * 256 + wr * 64 + fr, col0 = u.pn * 128 + wc * 32 + 8 * fq;
        float rsv[2][4];
#pragma unroll
        for (int ai = 0; ai < 2; ++ai)
#pragma unroll
            for (int m = 0; m < 4; ++m) rsv[ai][m] = ss_rstd(ss, row0 + ai * 128 + m * 16);
#pragma unroll
        for (int ai = 0; ai < 2; ++ai)
#pragma unroll
            for (int m = 0; m < 4; ++m) { const int r = row0 + ai * 128 + m * 16; const float rs = rsv[ai][m];
                float hv[8];
#pragma unroll
                for (int n = 0; n < 2; ++n)
#pragma unroll
                    for (int j = 0; j < 4; ++j) { const float g = acc[ai][0][m][n][j] * rs, up = acc[ai][1][m][n][j] * rs; hv[4 * n + j] = siluf_(g) * up; }
                v4u w; w.x = pk2(hv[0], hv[1]); w.y = pk2(hv[2], hv[3]); w.z = pk2(hv[4], hv[5]); w.w = pk2(hv[6], hv[7]);
                *(v4u*)(H + (size_t)r * DFF + col0) = w; }
    }
};
struct EpiSwiGLUQ {
    static constexpr bool PERM = true, AFTER_DRAIN = false;
    bf16* H; const float* ra; const float* bs;
    __device__ __forceinline__ void operator()(const f32x4 (&acc)[2][2][4][2], const Unit& u, int wr, int wc, int fr, int fq) const {
        const int row0 = u.pm * 256 + wr * 64 + fr, col0 = u.pn * 128 + wc * 32 + 8 * fq, bcol0 = u.pn * 256 + wc * 32 + 8 * fq;
        f32x4 bv[2][2]; float rsv[2][4];
#pragma unroll
        for (int bj = 0; bj < 2; ++bj)
#pragma unroll
            for (int n = 0; n < 2; ++n) bv[bj][n] = *(const f32x4*)(bs + bcol0 + bj * 128 + 4 * n);
#pragma unroll
        for (int ai = 0; ai < 2; ++ai)
#pragma unroll
            for (int m = 0; m < 4; ++m) rsv[ai][m] = ra[row0 + ai * 128 + m * 16];
#pragma unroll
        for (int ai = 0; ai < 2; ++ai)
#pragma unroll
            for (int m = 0; m < 4; ++m) { const int r = row0 + ai * 128 + m * 16; const float rs = rsv[ai][m];
                float hv[8];
#pragma unroll
                for (int n = 0; n < 2; ++n)
                {   const pg8::i32x4 gi = __builtin_bit_cast(pg8::i32x4, acc[ai][0][m][n]), ui = __builtin_bit_cast(pg8::i32x4, acc[ai][1][m][n]);
#pragma unroll
                    for (int j = 0; j < 4; ++j) { const float g = (float)gi[j] * (rs * bv[0][n][j]), up = (float)ui[j] * (rs * bv[1][n][j]);
                        hv[4 * n + j] = siluf_(g) * up; } }
                v4u w; w.x = pk2(hv[0], hv[1]); w.y = pk2(hv[2], hv[3]); w.z = pk2(hv[4], hv[5]); w.w = pk2(hv[6], hv[7]);
                *(v4u*)(H + (size_t)r * DFF + col0) = w; }
    }
};
struct EpiHgrnIn {
    static constexpr bool PERM = true, AFTER_DRAIN = false;
    bf16 *QT, *KT, *VI, *GS; float* DEC; const float* lb; const ssq_t* ss;
    __device__ __forceinline__ void operator()(f32x4 (&acc)[2][2][4][2], const Unit& u, int wr, int wc, int fr, int fq) const {
        const int row0 = u.pm * 256 + wr * 64 + fr;
        const int head = 4 * (u.pn >> 3) + (u.pn & 3);
        float rsv[2][4];
#pragma unroll
        for (int ai = 0; ai < 2; ++ai)
#pragma unroll
            for (int m = 0; m < 4; ++m) rsv[ai][m] = ss_rstd(ss, row0 + ai * 128 + m * 16);
        if (u.pn & 4) {
            const int col0 = head * 128 + wc * 32 + 8 * fq;
#pragma unroll
            for (int ai = 0; ai < 2; ++ai)
#pragma unroll
                for (int m = 0; m < 4; ++m) { const int r = row0 + ai * 128 + m * 16; const float rs = rsv[ai][m];
                    float a[8], g[8];
#pragma unroll
                    for (int n = 0; n < 2; ++n)
#pragma unroll
                        for (int j = 0; j < 4; ++j) { a[4 * n + j] = acc[ai][0][m][n][j] * rs; g[4 * n + j] = siluf_(acc[ai][1][m][n][j] * rs); }
                    v4u w; w.x = pk2(a[0], a[1]); w.y = pk2(a[2], a[3]); w.z = pk2(a[4], a[5]); w.w = pk2(a[6], a[7]); *(v4u*)(VI + (size_t)r * D + col0) = w;
                    w.x = pk2(g[0], g[1]); w.y = pk2(g[2], g[3]); w.z = pk2(g[4], g[5]); w.w = pk2(g[6], g[7]); *(v4u*)(GS + (size_t)r * D + col0) = w; }
            return;
        }
        const int col0 = head * 128 + wc * 32 + 8 * fq;
#pragma unroll
        for (int ai = 0; ai < 2; ++ai) {
            v2u hq[4], hk[4];
#pragma unroll
            for (int n = 0; n < 2; ++n) {
                float pf[4][4], lbv[4];
#pragma unroll
                for (int j = 0; j < 4; ++j) lbv[j] = 1.0f - lb[col0 + 4 * n + j];
#pragma unroll
                for (int m = 0; m < 4; ++m) { const float rs = rsv[ai][m];
#pragma unroll
                    for (int j = 0; j < 4; ++j) { const float ex = fast_exp2(acc[ai][1][m][n][j] * rs * LOG2E);
                        const float k1 = lbv[j] * fast_rcp(1.0f + ex);
                        acc[ai][1][m][n][j] = k1; pf[m][j] = 1.0f - k1;
                        acc[ai][0][m][n][j] = siluf_(acc[ai][0][m][n][j] * rs) * 0.08838834764831845f; }
                    __builtin_amdgcn_sched_barrier(0); }
                float run[4] = {1.f, 1.f, 1.f, 1.f};
#pragma unroll
                for (int m = 0; m < 4; ++m)
#pragma unroll
                    for (int j = 0; j < 4; ++j) { float v = pf[m][j];
                        v *= __builtin_bit_cast(float, __builtin_amdgcn_update_dpp(0x3f800000, __builtin_bit_cast(int, v), 0x111, 0xf, 0xf, false));
                        v *= __builtin_bit_cast(float, __builtin_amdgcn_update_dpp(0x3f800000, __builtin_bit_cast(int, v), 0x112, 0xf, 0xf, false));
                        v *= __builtin_bit_cast(float, __builtin_amdgcn_update_dpp(0x3f800000, __builtin_bit_cast(int, v), 0x114, 0xf, 0xf, false));
                        v *= __builtin_bit_cast(float, __builtin_amdgcn_update_dpp(0x3f800000, __builtin_bit_cast(int, v), 0x118, 0xf, 0xf, false));
                        const float tot = __shfl(v, 15, 16); pf[m][j] = v * run[j]; run[j] *= tot; }
#pragma unroll
                for (int m = 0; m < 4; ++m) { const int r = row0 + ai * 128 + m * 16; float qt[4], kt[4];
#pragma unroll
                    for (int j = 0; j < 4; ++j) { const float p = pf[m][j]; const float k1 = acc[ai][1][m][n][j];
                        qt[j] = acc[ai][0][m][n][j] * p; kt[j] = k1 * fast_rcp(p); }
                    v2u wq, wk; const unsigned off = (unsigned)r * D + col0;
                    wq.x = pk2(qt[0], qt[1]); wq.y = pk2(qt[2], qt[3]); wk.x = pk2(kt[0], kt[1]); wk.y = pk2(kt[2], kt[3]);
                    if (n == 0) { hq[m] = wq; hk[m] = wk; }
                    else { *(v4u*)(QT + off) = (v4u){hq[m].x, hq[m].y, wq.x, wq.y}; *(v4u*)(KT + off) = (v4u){hk[m].x, hk[m].y, wk.x, wk.y}; }
                    __builtin_amdgcn_sched_barrier(0); }
                if (fr == 0) { const int chunk = u.pm * 4 + ai * 2 + wr; *(f32x4*)(DEC + (unsigned)chunk * D + col0 + 4 * n) = (f32x4){run[0], run[1], run[2], run[3]}; }
                asm volatile("" ::: "memory");
            } }
    }
};

__device__ __forceinline__ int dst_row(int map, int n) {
    if (map == 0) return n;
    if (map == 1) { const int up = n >= DFF ? 1 : 0, j = n - up * DFF; return 256 * (j >> 7) + 128 * up + (j & 127); }
    const int part = n >> 12, j = n & 4095, head = j >> 7, d = j & 127; return 256 * (8 * (head >> 2) + 4 * (part >> 1) + (head & 3)) + 128 * (part & 1) + d;
}
struct CvItem { const float* W; bf16* WT; const float* kw; int K, N, map, item; };
__device__ __forceinline__ void cv_load(const CvItem& c, int lane, float (&v)[32], float& kwa) {
    const int nblk = c.N / 32, kb = c.item / nblk, nb = c.item % nblk, k0 = 64 * kb, n0 = 32 * nb;
    kwa = c.kw ? c.kw[k0 + lane] : 1.0f;
    const float* src = c.W + (size_t)(k0 + (lane >> 5)) * c.N + n0 + (lane & 31);
#pragma unroll
    for (int i = 0; i < 32; ++i) v[i] = __builtin_nontemporal_load(src + (size_t)(2 * i) * c.N);
}
__device__ __forceinline__ void cv_store(const CvItem& c, int lane, const float (&v)[32], float kwa, LAS float* scr) {
    const int nblk = c.N / 32, kb = c.item / nblk, nb = c.item % nblk, k0 = 64 * kb, n0 = 32 * nb;
#pragma unroll
    for (int i = 0; i < 32; ++i) { const int kk = 2 * i + (lane >> 5); scr[kk * 33 + (lane & 31)] = v[i] * __shfl(kwa, kk); }
    LDS_WAIT(); asm volatile("" ::: "memory");
    const int cc = lane & 7; const int r0 = dst_row(c.map, n0);
#pragma unroll
    for (int j = 0; j < 4; ++j) { const int n = (lane >> 3) + 8 * j; const LAS float* s = scr + (8 * cc) * 33 + n;
        v4u o; o.x = pk2(s[0 * 33], s[1 * 33]); o.y = pk2(s[2 * 33], s[3 * 33]); o.z = pk2(s[4 * 33], s[5 * 33]); o.w = pk2(s[6 * 33], s[7 * 33]);
        __builtin_nontemporal_store(o, (GAS v4u*)(c.WT + (size_t)(r0 + n) * c.K + k0 + 8 * cc)); }
    LDS_WAIT(); asm volatile("" ::: "memory");
}
__device__ __forceinline__ void row_to_bf16_ss(const float* xrow, bf16* orow, ssq_t* ssrow, int lane, signed char* qrow = nullptr, float* qscale = nullptr) {
    const GAS f32x4* xr = (const GAS f32x4*)xrow + lane;
    f32x4 v[16]; float s = 0.f;
#pragma unroll
    for (int j = 0; j < 16; ++j) { v[j] = xr[64 * j]; s += (v[j].x * v[j].x + v[j].y * v[j].y) + (v[j].z * v[j].z + v[j].w * v[j].w); }
    s = wave_sum(s);
    if (qrow) {
        float amax = 0.f;
#pragma unroll
        for (int j = 0; j < 16; ++j) amax = fmaxf(fmaxf(amax, fmaxf(fabsf(v[j].x), fabsf(v[j].y))), fmaxf(fabsf(v[j].z), fabsf(v[j].w)));
        amax = wave_max(amax); const float inv = amax > 0.f ? 127.0f / amax : 0.f;
        GAS unsigned* q4 = (GAS unsigned*)qrow + lane;
#pragma unroll
        for (int j = 0; j < 16; ++j) { const int a = (int)__builtin_rintf(v[j].x * inv), b = (int)__builtin_rintf(v[j].y * inv), c = (int)__builtin_rintf(v[j].z * inv), d = (int)__builtin_rintf(v[j].w * inv);
            q4[64 * j] = (unsigned)(a & 255) | ((unsigned)(b & 255) << 8) | ((unsigned)(c & 255) << 16) | ((unsigned)(d & 255) << 24); }
        if (lane == 0) *qscale = amax * (1.0f / 127.0f) * __builtin_amdgcn_rsqf(s * (1.0f / D) + RMS_EPS);
    }
    GAS v2u* o8 = (GAS v2u*)orow + lane;
#pragma unroll
    for (int j = 0; j < 16; ++j) { v2u p; p.x = pk2(v[j].x, v[j].y); p.y = pk2(v[j].z, v[j].w); o8[64 * j] = p; }
    if (lane == 0) *ssrow = ss_fix(s);
}

template <int NBK> __device__ __forceinline__ void sgemm_unit(const bf16* A, int K, const bf16* B0, const bf16* B1, LAS float* red, int wave, int lane, int tid, float (&out)[NBK]) {
    const int fr = lane & 15, fq = lane >> 4;
    f32x4 acc[NBK][2];
#pragma unroll
    for (int nb = 0; nb < NBK; ++nb) { acc[nb][0] = (f32x4){0.f, 0.f, 0.f, 0.f}; acc[nb][1] = (f32x4){0.f, 0.f, 0.f, 0.f}; }
    const bf16* a0p = A + (size_t)fr * K + fq * 32; const bf16* a1p = a0p + (size_t)16 * K;
    const bf16* b0p = B0 + (size_t)fr * K + fq * 32; const bf16* b1p = B1 + (size_t)fr * K + fq * 32;
    const int ns = K >> 7;
    for (int s = wave; s < ns; s += 24) {
        bf16x8 a0[3][4], a1[3][4], b0[3][4], b1[3][4];
#pragma unroll
        for (int g = 0; g < 3; ++g) { const int sg = s + 8 * g < ns ? s + 8 * g : s; const int off = sg * 128;
#pragma unroll
            for (int j = 0; j < 4; ++j) { a0[g][j] = *(const bf16x8*)(a0p + off + 8 * j); a1[g][j] = *(const bf16x8*)(a1p + off + 8 * j); b0[g][j] = *(const bf16x8*)(b0p + off + 8 * j); if (NBK > 1) b1[g][j] = *(const bf16x8*)(b1p + off + 8 * j); } }
#pragma unroll
        for (int g = 0; g < 3; ++g) { if (s + 8 * g < ns) {
#pragma unroll
            for (int j = 0; j < 4; ++j) { acc[0][0] = MFMA16(b0[g][j], a0[g][j], acc[0][0]); acc[0][1] = MFMA16(b0[g][j], a1[g][j], acc[0][1]);
                if (NBK > 1) { acc[NBK - 1][0] = MFMA16(b1[g][j], a0[g][j], acc[NBK - 1][0]); acc[NBK - 1][1] = MFMA16(b1[g][j], a1[g][j], acc[NBK - 1][1]); } } } }
    }
#pragma unroll
    for (int nb = 0; nb < NBK; ++nb)
#pragma unroll
        for (int rb = 0; rb < 2; ++rb) *(LAS f32x4*)(red + (((wave * NBK + nb) * 2 + rb) * 64 + lane) * 4) = acc[nb][rb];
    __syncthreads();
    const int row = tid >> 4, n = tid & 15, rb = row >> 4, lp = (n >> 2) * 16 + (row & 15), rg = n & 3;
#pragma unroll
    for (int nb = 0; nb < NBK; ++nb) { float s = 0.f;
#pragma unroll
        for (int w = 0; w < 8; ++w) s += red[(((w * NBK + nb) * 2 + rb) * 64 + lp) * 4 + rg];
        out[nb] = s; }
    __syncthreads();
}

struct SampleA { bf16x8 a0[4][4], a1[4][4]; };
__device__ __forceinline__ void sample_load_a(SampleA& sa, const bf16* A, int wave, int lane) {
    const int fr = lane & 15, fq = lane >> 4; const bf16* p = A + (size_t)fr * D + fq * 32 + wave * 128;
#pragma unroll
    for (int s = 0; s < 4; ++s)
#pragma unroll
        for (int j = 0; j < 4; ++j) { sa.a0[s][j] = *(const bf16x8*)(p + s * 1024 + 8 * j); sa.a1[s][j] = *(const bf16x8*)(p + (size_t)16 * D + s * 1024 + 8 * j); }
}
template <int NBK> __device__ __forceinline__ void sgemm_unit_ra(const SampleA& sa, const bf16* B0, const bf16* B1, LAS float* red, int wave, int lane, int tid, float (&out)[NBK]) {
    const int fr = lane & 15, fq = lane >> 4;
#pragma unroll
    for (int nb = 0; nb < NBK; ++nb) { const bf16* bp = (nb == 0 ? B0 : B1) + (size_t)fr * D + fq * 32 + wave * 128;
        bf16x8 b[4][4];
#pragma unroll
        for (int s = 0; s < 4; ++s)
#pragma unroll
            for (int j = 0; j < 4; ++j) b[s][j] = *(const bf16x8*)(bp + s * 1024 + 8 * j);
        f32x4 c0 = (f32x4){0.f, 0.f, 0.f, 0.f}, c1 = (f32x4){0.f, 0.f, 0.f, 0.f};
#pragma unroll
        for (int s = 0; s < 4; ++s)
#pragma unroll
            for (int j = 0; j < 4; ++j) { c0 = MFMA16(b[s][j], sa.a0[s][j], c0); c1 = MFMA16(b[s][j], sa.a1[s][j], c1); }
        *(LAS f32x4*)(red + (((wave * NBK + nb) * 2 + 0) * 64 + lane) * 4) = c0; *(LAS f32x4*)(red + (((wave * NBK + nb) * 2 + 1) * 64 + lane) * 4) = c1; }
    __syncthreads();
    const int row = tid >> 4, n = tid & 15, rb = row >> 4, lp = (n >> 2) * 16 + (row & 15), rg = n & 3;
#pragma unroll
    for (int nb = 0; nb < NBK; ++nb) { float s = 0.f;
#pragma unroll
        for (int w = 0; w < 8; ++w) s += red[(((w * NBK + nb) * 2 + rb) * 64 + lp) * 4 + rg];
        out[nb] = s; }
    __syncthreads();
}

typedef int v4i_t __attribute__((ext_vector_type(4)));
struct SampleA8 { v4i_t a0[2][4], a1[2][4]; };
__device__ __forceinline__ void sample_load_a8(SampleA8& sa, const signed char* A, int wave, int lane) {
    const int fr = lane & 15, fq = lane >> 4; const signed char* p = A + (size_t)fr * D + fq * 64 + wave * 256;
#pragma unroll
    for (int s = 0; s < 2; ++s)
#pragma unroll
        for (int j = 0; j < 4; ++j) { sa.a0[s][j] = *(const v4i_t*)(p + s * 2048 + 16 * j); sa.a1[s][j] = *(const v4i_t*)(p + (size_t)16 * D + s * 2048 + 16 * j); }
}
__device__ __forceinline__ void sgemm_unit_i8x2(const SampleA8& sa, const signed char* B0, const signed char* B1, LAS float* red, int wave, int lane, int tid, float (&out)[2]) {
    const int fr = lane & 15, fq = lane >> 4;
    v4i_t b[2][2][4];
#pragma unroll
    for (int nb = 0; nb < 2; ++nb) { const signed char* bp = (nb == 0 ? B0 : B1) + (size_t)fr * D + fq * 64 + wave * 256;
#pragma unroll
        for (int s = 0; s < 2; ++s)
#pragma unroll
            for (int j = 0; j < 4; ++j) b[nb][s][j] = *(const v4i_t*)(bp + s * 2048 + 16 * j); }
#pragma unroll
    for (int nb = 0; nb < 2; ++nb) { v4i_t c0 = (v4i_t){0, 0, 0, 0}, c1 = (v4i_t){0, 0, 0, 0};
#pragma unroll
        for (int s = 0; s < 2; ++s)
#pragma unroll
            for (int j = 0; j < 4; ++j) { c0 = __builtin_amdgcn_mfma_i32_16x16x64_i8(b[nb][s][j], sa.a0[s][j], c0, 0, 0, 0); c1 = __builtin_amdgcn_mfma_i32_16x16x64_i8(b[nb][s][j], sa.a1[s][j], c1, 0, 0, 0); }
        *(LAS v4i_t*)(red + (((wave * 2 + nb) * 2 + 0) * 64 + lane) * 4) = c0; *(LAS v4i_t*)(red + (((wave * 2 + nb) * 2 + 1) * 64 + lane) * 4) = c1; }
    __syncthreads();
    const int row = tid >> 4, n = tid & 15, rb = row >> 4, lp = (n >> 2) * 16 + (row & 15), rg = n & 3;
#pragma unroll
    for (int nb = 0; nb < 2; ++nb) { int s = 0;
#pragma unroll
        for (int w = 0; w < 8; ++w) s += ((const LAS int*)red)[(((w * 2 + nb) * 2 + rb) * 64 + lp) * 4 + rg];
        out[nb] = (float)s; }
    __syncthreads();
}

#define LDS_BARRIER() do { asm volatile("s_waitcnt lgkmcnt(0)" ::: "memory"); __builtin_amdgcn_s_barrier(); asm volatile("" ::: "memory"); } while (0)
constexpr int AT_KS = 144, AT_VS = 192, AT_KOFF = 0, AT_VOFF = 256 * AT_KS;
static_assert(AT_VOFF + 256 * AT_VS <= RING_BYTES, "attention LDS");
struct AttnKV { v4u k[4], v[4]; };
__device__ __forceinline__ void attn_kv_load(AttnKV& t, const bf16* Kb, const bf16* Vb, int b, int hkv, int n, int tid) {
    const int r0 = b * SEQ + n * 128;
#pragma unroll
    for (int i = 0; i < 4; ++i) { const int p = tid + 512 * i, key = p >> 3, ch = p & 7; const int gr = r0 - 128 + key; t.k[i] = (v4u){0u, 0u, 0u, 0u}; t.v[i] = (v4u){0u, 0u, 0u, 0u};
        if (n > 0 || key >= 128) { t.k[i] = *(const v4u*)(Kb + (size_t)gr * KVD + hkv * 64 + ch * 8); t.v[i] = *(const v4u*)(Vb + (size_t)gr * KVD + hkv * 64 + ch * 8); } }
}
__device__ __forceinline__ void attn_kv_store(const AttnKV& t, LAS unsigned char* lds, int tid) {
#pragma unroll
    for (int i = 0; i < 4; ++i) { const int p = tid + 512 * i, key = p >> 3, ch = p & 7; *(LAS v4u*)(lds + AT_KOFF + key * AT_KS + ch * 16) = t.k[i]; *(LAS v4u*)(lds + AT_VOFF + key * AT_VS + ch * 16) = t.v[i]; }
}
__device__ __forceinline__ void attn_prompt_unit(LAS unsigned char* lds, const bf16* Q, const bf16* Kb, const bf16* Vb, bf16* O, const float* sinks, int b, int hkv, int n, AttnKV& kv, bool has_next, int nb, int nhkv, int nn, int tid, int wave, int lane) {
    const int r0 = b * SEQ + n * 128;
    LDS_BARRIER();
    attn_kv_store(kv, lds, tid);
    LDS_BARRIER();
    const int hq = hkv * 8 + wave, h = lane >> 5, l31 = lane & 31, i16 = lane & 15, q4 = i16 >> 2, p4 = i16 & 3, blk = (lane >> 4) & 1;
    const float sink2 = sinks[hq] * LOG2E; const float sc2 = 0.125f * LOG2E; const float ninf = -__builtin_inff();
    bf16x8 qf[4], qn[4];
    { const bf16* qp = Q + (size_t)(r0 + l31) * D + hq * 64 + 8 * h;
#pragma unroll
      for (int ks = 0; ks < 4; ++ks) qf[ks] = *(const bf16x8*)(qp + ks * 16); }
    for (int qs = 0; qs < 4; ++qs) {
        if (qs < 3) { const bf16* qp = Q + (size_t)(r0 + (qs + 1) * 32 + l31) * D + hq * 64 + 8 * h;
#pragma unroll
            for (int ks = 0; ks < 4; ++ks) qn[ks] = *(const bf16x8*)(qp + ks * 16); }
        else if (has_next) attn_kv_load(kv, Kb, Vb, nb, nhkv, nn, tid);
        f32x16 st[5];
        const int qi = qs * 32 + l31; float mx = sink2;
        const LAS unsigned char* kbase = lds + AT_KOFF + (qs * 32 + l31) * AT_KS + 16 * h;
#pragma unroll
        for (int i = 0; i < 5; ++i) { f32x16 a;
#pragma unroll
            for (int r = 0; r < 16; ++r) a[r] = 0.f;
#pragma unroll
            for (int ks = 0; ks < 4; ++ks) { const bf16x8 kf = *(const LAS bf16x8*)(kbase + i * 32 * AT_KS + ks * 32); a = MFMA32(kf, qf[ks], a); }
            const bool prevblk = (qs + i) < 4;
            if (prevblk && n == 0) {
#pragma unroll
                for (int r = 0; r < 16; ++r) a[r] = ninf;
            } else if (i == 0) {
#pragma unroll
                for (int r = 0; r < 16; ++r) { const float s = (crow(r, h) > l31) ? a[r] * sc2 : ninf; a[r] = s; mx = fmaxf(mx, s); }
            } else if (i == 4) {
#pragma unroll
                for (int r = 0; r < 16; ++r) { const float s = (crow(r, h) <= l31) ? a[r] * sc2 : ninf; a[r] = s; mx = fmaxf(mx, s); }
            } else {
#pragma unroll
                for (int r = 0; r < 16; ++r) { const float s = a[r] * sc2; a[r] = s; mx = fmaxf(mx, s); }
            }
            st[i] = a; }
        mx = fmaxf(mx, __shfl_xor(mx, 32));
        float sum = 0.f;
#pragma unroll
        for (int i = 0; i < 5; ++i)
#pragma unroll
            for (int r = 0; r < 16; ++r) { const float p = fast_exp2(st[i][r] - mx); st[i][r] = p; sum += p; }
        sum += __shfl_xor(sum, 32);
        const float inv = fast_rcp(sum + fast_exp2(sink2 - mx));
        f32x16 oa[2];
#pragma unroll
        for (int r = 0; r < 16; ++r) { oa[0][r] = 0.f; oa[1][r] = 0.f; }
        const LAS unsigned char* vbase = lds + AT_VOFF + (qs * 32 + 4 * h + q4) * AT_VS + 32 * blk + 8 * p4;
#pragma unroll
        for (int i = 0; i < 5; ++i)
#pragma unroll
            for (int s = 0; s < 2; ++s) { v4u pw; pw.x = pk2(st[i][8 * s + 0], st[i][8 * s + 1]); pw.y = pk2(st[i][8 * s + 2], st[i][8 * s + 3]); pw.z = pk2(st[i][8 * s + 4], st[i][8 * s + 5]); pw.w = pk2(st[i][8 * s + 6], st[i][8 * s + 7]);
                const bf16x8 pf = __builtin_bit_cast(bf16x8, pw);
#pragma unroll
                for (int db = 0; db < 2; ++db) { const LAS unsigned char* vp = vbase + (i * 32 + 16 * s) * AT_VS + db * 64;
                    const bf16x8 vf = tr_frag(vp, vp + 8 * AT_VS); oa[db] = MFMA32(vf, pf, oa[db]); } }
        bf16* op = O + (size_t)(r0 + qs * 32 + l31) * D + hq * 64;
#pragma unroll
        for (int db = 0; db < 2; ++db)
#pragma unroll
            for (int g4 = 0; g4 < 4; ++g4) { v2u w; w.x = pk2(oa[db][4 * g4] * inv, oa[db][4 * g4 + 1] * inv); w.y = pk2(oa[db][4 * g4 + 2] * inv, oa[db][4 * g4 + 3] * inv); *(v2u*)(op + db * 32 + 8 * g4 + 4 * h) = w; }
#pragma unroll
        for (int ks = 0; ks < 4; ++ks) qf[ks] = qn[ks];
    }
}
__device__ __forceinline__ void attn_sample_unit(LAS unsigned char* lds, const bf16* Q, const bf16* Kb, const bf16* Vb, bf16* O, const float* sinks, const float* ck, const float* cv, float* wks, float* wvs, int sb, int hkv, int tid, int wave, int lane) {
    LAS float* Ks = (LAS float*)lds; LAS float* Vs = Ks + 128 * 65; LAS float* qs = Vs + 128 * 64; LAS float* sc = qs + 512;
    __syncthreads();
#pragma unroll 4
    for (int i = 0; i < 16; ++i) { const int idx = tid + 512 * i, j = idx >> 6, d = idx & 63; float kv, vv;
        if (j < 127) { const size_t g = ((size_t)(sb * 128 + j + 1) * 8 + hkv) * 64 + d; kv = ck[g]; vv = cv[g]; const size_t o = ((size_t)(sb * 128 + j) * 8 + hkv) * 64 + d; wks[o] = kv; wvs[o] = vv; }
        else { kv = bf2f(Kb[(size_t)(MP + sb) * KVD + hkv * 64 + d]); vv = bf2f(Vb[(size_t)(MP + sb) * KVD + hkv * 64 + d]); }
        Ks[j * 65 + d] = kv; Vs[j * 64 + d] = vv; }
    qs[tid] = bf2f(Q[(size_t)(MP + sb) * D + hkv * 512 + tid]);
    __syncthreads();
#pragma unroll
    for (int i = 0; i < 2; ++i) { const int idx = tid + 512 * i, g = idx >> 7, j = idx & 127; float s = 0.f;
#pragma unroll 16
        for (int d = 0; d < 64; ++d) s += qs[g * 64 + d] * Ks[j * 65 + d];
        sc[idx] = s * 0.125f; }
    __syncthreads();
    { const float snk = sinks[hkv * 8 + wave]; const float s0 = sc[wave * 128 + lane], s1 = sc[wave * 128 + 64 + lane];
      const float m = fmaxf(wave_max(fmaxf(s0, s1)), snk); const float e0 = __expf(s0 - m), e1 = __expf(s1 - m); const float den = wave_sum(e0 + e1) + __expf(snk - m);
      sc[wave * 128 + lane] = e0 / den; sc[wave * 128 + 64 + lane] = e1 / den; }
    __syncthreads();
    { const int g = tid >> 6, d = tid & 63; float o = 0.f;
#pragma unroll 16
      for (int j = 0; j < 128; ++j) o += sc[g * 128 + j] * Vs[j * 64 + d];
      O[(size_t)(MP + sb) * D + hkv * 512 + tid] = (bf16)(pk2(o, 0.f) & 0xffffu); }
}

__device__ __forceinline__ void quant_load(v4u (&x)[8], const bf16* src, int lane) {
#pragma unroll
    for (int i = 0; i < 8; ++i) x[i] = *(const v4u*)(src + (i * 64 + lane) * 8);
}
__device__ __forceinline__ void quant_finish(const v4u (&x)[8], signed char* dst, float* scale_out, float extra, int lane) {
    float amax = 0.f;
#pragma unroll
    for (int i = 0; i < 8; ++i) { const unsigned w_[4] = {x[i].x, x[i].y, x[i].z, x[i].w};
#pragma unroll
        for (int e = 0; e < 4; ++e) { amax = fmaxf(amax, fabsf(__builtin_bit_cast(float, w_[e] << 16))); amax = fmaxf(amax, fabsf(__builtin_bit_cast(float, w_[e] & 0xffff0000u))); } }
    amax = wave_max(amax);
    const float inv = amax > 0.f ? 127.0f / amax : 0.f;
#pragma unroll
    for (int i = 0; i < 8; ++i) { const unsigned w_[4] = {x[i].x, x[i].y, x[i].z, x[i].w}; unsigned q[2] = {0u, 0u};
#pragma unroll
        for (int e = 0; e < 4; ++e) { const int a = (int)__builtin_rintf(__builtin_bit_cast(float, w_[e] << 16) * inv), b = (int)__builtin_rintf(__builtin_bit_cast(float, w_[e] & 0xffff0000u) * inv);
            q[e >> 1] |= ((unsigned)(a & 255) | ((unsigned)(b & 255) << 8)) << (16 * (e & 1)); }
        *(v2u*)(dst + (i * 64 + lane) * 8) = (v2u){q[0], q[1]}; }
    if (lane == 0) *scale_out = amax * (1.0f / 127.0f) * extra;
}
__device__ __forceinline__ void quant_row_i8(const bf16* src, signed char* dst, float* scale_out, float extra, int lane) { v4u x[8]; quant_load(x, src, lane); quant_finish(x, dst, scale_out, extra, lane); }
template <class F> __device__ __forceinline__ void quant_rows_i8(int r0, int rend, int rstep, int lane, F f) {
    if (r0 >= rend) return;
    v4u xa[8], xb[8]; const bf16* src; signed char *da, *db; float *sa, *sb; float ea, eb;
    int r = r0; f(r, src, da, sa, ea); quant_load(xa, src, lane);
    for (;;) {
        const int r1 = r + rstep; const bool h1 = r1 < rend;
        if (h1) { f(r1, src, db, sb, eb); quant_load(xb, src, lane); }
        quant_finish(xa, da, sa, ea, lane);
        if (!h1) break;
        const int r2 = r1 + rstep; const bool h2 = r2 < rend;
        if (h2) { f(r2, src, da, sa, ea); quant_load(xa, src, lane); }
        quant_finish(xb, db, sb, eb, lane);
        if (!h2) break;
        r = r2;
    }
}

constexpr int GL_QT = 0, GL_KT = 17408, GL_KP = 34816, GL_V = 55296, GL_AM = 75776, GL_ST = 84992, GL_DEC = 119808, GL_PART = 120320, GL_END = 121344;
constexpr int GS_R = 272, GS_T = 320, GS_A = 144;
static_assert(GL_END <= RING_BYTES && GL_KT == 64 * GS_R && GL_KP == GL_KT + 64 * GS_R && GL_V == GL_KP + 64 * GS_T && GL_AM == GL_V + 64 * GS_T && GL_ST == GL_AM + 64 * GS_A && GL_DEC == GL_ST + 128 * GS_R, "GLA LDS map");
__device__ __forceinline__ void gla_prompt_seq(LAS unsigned char* lds, const bf16* QT, const bf16* KT, const bf16* VI, const bf16* GS, const float* DEC, const float* nw, bf16* OG, float* state_out,
                                               int b, int hh, int tid, int wave, int lane) {
    const int h = lane >> 5, l31 = lane & 31, i16 = lane & 15, q4 = i16 >> 2, p4 = i16 & 3, blk = (lane >> 4) & 1;
    const int kb = wave >> 1, vb0 = 2 * (wave & 1);
    const int tb = wave >> 2, vbo = wave & 3;
    __syncthreads();
    for (int i = tid * 16; i < GL_DEC - GL_AM; i += 512 * 16) *(LAS v4u*)(lds + GL_AM + i) = (v4u){0u, 0u, 0u, 0u};
    f32x16 S0, S1;
#pragma unroll
    for (int r = 0; r < 16; ++r) { S0[r] = 0.f; S1[r] = 0.f; }
    float nwv[16];
#pragma unroll
    for (int r = 0; r < 16; ++r) nwv[r] = nw[vbo * 32 + crow(r, h)];
    const int lrow0 = tid >> 4, lc16 = tid & 15; const int R0 = b * SEQ; const size_t gcol = (size_t)hh * 128 + lc16 * 8;
    v4u pqA[2], pkA[2], pvA[2], pqB[2], pkB[2], pvB[2]; float pdA = 0.f, pdB = 0.f; v2u gsE[4], gsO[4];
#define GLA_LOAD(X, c) do { if ((c) < 32) { _Pragma("unroll") for (int i_ = 0; i_ < 2; ++i_) { const size_t g_ = (size_t)(R0 + (c) * 64 + lrow0 + 32 * i_) * D + gcol; \
        pq##X[i_] = *(const v4u*)(QT + g_); pk##X[i_] = *(const v4u*)(KT + g_); pv##X[i_] = *(const v4u*)(VI + g_); } \
        if (tid < 128) pd##X = DEC[(size_t)(b * 32 + (c)) * D + hh * 128 + tid]; } } while (0)
#define GLA_STORE(X) do { _Pragma("unroll") for (int i_ = 0; i_ < 2; ++i_) { const int r_ = lrow0 + 32 * i_; \
        *(LAS v4u*)(lds + GL_QT + r_ * GS_R + lc16 * 16) = pq##X[i_]; *(LAS v4u*)(lds + GL_KT + r_ * GS_R + lc16 * 16) = pk##X[i_]; \
        *(LAS v4u*)(lds + GL_KP + r_ * GS_T + lc16 * 16) = pk##X[i_]; *(LAS v4u*)(lds + GL_V + r_ * GS_T + lc16 * 16) = pv##X[i_]; } \
        if (tid < 128) *(LAS float*)(lds + GL_DEC + tid * 4) = pd##X; } while (0)
#define GLA_GS(G, c) do { if ((c) < 32) { _Pragma("unroll") for (int g4_ = 0; g4_ < 4; ++g4_) G[g4_] = *(const v2u*)(GS + (size_t)(R0 + (c) * 64 + tb * 32 + l31) * D + hh * 128 + vbo * 32 + 8 * g4_ + 4 * h); } } while (0)
#define GLA_CHUNK(c, X, G) do { \
        LDS_BARRIER();                                                     \
        const int trow = R0 + (c) * 64 + tb * 32 + l31; \
        { bf16x8 kpf[4], vf0[4], vf1[4];                                     \
          _Pragma("unroll") for (int ts = 0; ts < 4; ++ts) { const int t0 = 16 * ts + 8 * h + q4; \
            const LAS unsigned char* ka = lds + GL_KP + t0 * GS_T + (kb * 32 + 16 * blk) * 2 + 8 * p4; kpf[ts] = tr_frag(ka, ka + 4 * GS_T); \
            const LAS unsigned char* va = lds + GL_V + t0 * GS_T + (vb0 * 32 + 16 * blk) * 2 + 8 * p4; vf0[ts] = tr_frag(va, va + 4 * GS_T); vf1[ts] = tr_frag(va + 64, va + 64 + 4 * GS_T); } \
          _Pragma("unroll") for (int ts = 0; ts < 4; ++ts) { S0 = MFMA32(kpf[ts], vf0[ts], S0); S1 = MFMA32(kpf[ts], vf1[ts], S1); } } \
        _Pragma("unroll") for (int r = 0; r < 16; ++r) { const float dc = *(const LAS float*)(lds + GL_DEC + (kb * 32 + crow(r, h)) * 4); S0[r] *= dc; S1[r] *= dc; }     \
        if (wave < 3) { const int tbp = wave > 0 ? 1 : 0, sb = wave == 2 ? 1 : 0; f32x16 a; \
            _Pragma("unroll") for (int r = 0; r < 16; ++r) a[r] = 0.f; \
            bf16x8 kf[8], qf[8]; \
            _Pragma("unroll") for (int ks = 0; ks < 8; ++ks) { kf[ks] = *(const LAS bf16x8*)(lds + GL_KT + (sb * 32 + l31) * GS_R + (ks * 16 + 8 * h) * 2); qf[ks] = *(const LAS bf16x8*)(lds + GL_QT + (tbp * 32 + l31) * GS_R + (ks * 16 + 8 * h) * 2); } \
            _Pragma("unroll") for (int ks = 0; ks < 8; ++ks) a = MFMA32(kf[ks], qf[ks], a); \
            const int t_ = tbp * 32 + l31; \
            _Pragma("unroll") for (int g4 = 0; g4 < 4; ++g4) { float x[4]; \
                _Pragma("unroll") for (int j = 0; j < 4; ++j) { const int sp = sb * 32 + 8 * g4 + 4 * h + j; x[j] = (sp <= t_) ? a[4 * g4 + j] : 0.f; } \
                v2u w; w.x = pk2(x[0], x[1]); w.y = pk2(x[2], x[3]); *(LAS v2u*)(lds + GL_AM + t_ * GS_A + (sb * 32 + 8 * g4 + 4 * h) * 2) = w; } } \
        LDS_BARRIER();                                                     \
        f32x16 o; \
        _Pragma("unroll") for (int r = 0; r < 16; ++r) o[r] = 0.f; \
        const int t = tb * 32 + l31; \
        { bf16x8 sf[8], qf[8], vf[4], af[4]; \
          _Pragma("unroll") for (int ks = 0; ks < 8; ++ks) { sf[ks] = *(const LAS bf16x8*)(lds + GL_ST + (vbo * 32 + l31) * GS_R + (ks * 16 + 8 * h) * 2); qf[ks] = *(const LAS bf16x8*)(lds + GL_QT + t * GS_R + (ks * 16 + 8 * h) * 2); } \
          _Pragma("unroll") for (int ks = 0; ks < 4; ++ks) { const LAS unsigned char* va = lds + GL_V + (16 * ks + 8 * h + q4) * GS_T + (vbo * 32 + 16 * blk) * 2 + 8 * p4; vf[ks] = tr_frag(va, va + 4 * GS_T); \
            af[ks] = *(const LAS bf16x8*)(lds + GL_AM + t * GS_A + (ks * 16 + 8 * h) * 2); } \
          _Pragma("unroll") for (int ks = 0; ks < 8; ++ks) o = MFMA32(sf[ks], qf[ks], o); \
          _Pragma("unroll") for (int ks = 0; ks < 4; ++ks) o = MFMA32(vf[ks], af[ks], o); } \
        float sq = 0.f; \
        _Pragma("unroll") for (int r = 0; r < 16; ++r) sq += o[r] * o[r]; \
        sq += __shfl_xor(sq, 32); \
        if (h == 0) *(LAS float*)(lds + GL_PART + (vbo * 64 + t) * 4) = sq; \
        LDS_BARRIER();                                                     \
        { const LAS float* pp_ = (const LAS float*)(lds + GL_PART); const float tot = (pp_[t] + pp_[64 + t]) + (pp_[128 + t] + pp_[192 + t]); const float rstd = __builtin_amdgcn_rsqf(tot * (1.0f / 128.0f) + RMS_EPS); \
          _Pragma("unroll") for (int g4 = 0; g4 < 4; ++g4) { const float g0 = __builtin_bit_cast(float, G[g4].x << 16), g1 = __builtin_bit_cast(float, G[g4].x & 0xffff0000u), g2 = __builtin_bit_cast(float, G[g4].y << 16), g3 = __builtin_bit_cast(float, G[g4].y & 0xffff0000u); \
              v2u w; w.x = pk2(o[4 * g4] * rstd * nwv[4 * g4] * g0, o[4 * g4 + 1] * rstd * nwv[4 * g4 + 1] * g1); w.y = pk2(o[4 * g4 + 2] * rstd * nwv[4 * g4 + 2] * g2, o[4 * g4 + 3] * rstd * nwv[4 * g4 + 3] * g3); \
              *(v2u*)(OG + (size_t)trow * D + hh * 128 + vbo * 32 + 8 * g4 + 4 * h) = w; } } \
        _Pragma("unroll") for (int g4 = 0; g4 < 4; ++g4) { v2u w0, w1; w0.x = pk2(S0[4 * g4], S0[4 * g4 + 1]); w0.y = pk2(S0[4 * g4 + 2], S0[4 * g4 + 3]); w1.x = pk2(S1[4 * g4], S1[4 * g4 + 1]); w1.y = pk2(S1[4 * g4 + 2], S1[4 * g4 + 3]); \
            *(LAS v2u*)(lds + GL_ST + (vb0 * 32 + l31) * GS_R + (kb * 32 + 8 * g4 + 4 * h) * 2) = w0; *(LAS v2u*)(lds + GL_ST + ((vb0 + 1) * 32 + l31) * GS_R + (kb * 32 + 8 * g4 + 4 * h) * 2) = w1; } \
        if ((c) + 1 < 32) GLA_STORE(X); \
        GLA_LOAD(X, (c) + 3); GLA_GS(G, (c) + 2); \
    } while (0)
    GLA_LOAD(B, 0); GLA_STORE(B);
    GLA_LOAD(A, 1); GLA_LOAD(B, 2); GLA_GS(gsE, 0); GLA_GS(gsO, 1);
    for (int c = 0; c < 32; c += 2) {
        GLA_CHUNK(c, A, gsE);
        GLA_CHUNK(c + 1, B, gsO);
    }
#undef GLA_LOAD
#undef GLA_STORE
#undef GLA_GS
#undef GLA_CHUNK
    float* so = state_out + ((size_t)(b * 32 + hh) * 128 + kb * 32) * 128 + vb0 * 32 + l31;
#pragma unroll
    for (int r = 0; r < 16; ++r) { so[(size_t)crow(r, h) * 128] = S0[r]; so[(size_t)crow(r, h) * 128 + 32] = S1[r]; }
}
__device__ __forceinline__ void gla_sample_unit(LAS unsigned char* lds, const float* sraw, const float* st_in, const float* lb, const float* nw, bf16* OG, float* st_out, int sb, int hh, int tid, int wave, int lane) {
    LAS float* fk = (LAS float*)lds; LAS float* kk = fk + 128; LAS float* qv = kk + 128; LAS float* iv = qv + 128; LAS float* part = iv + 128; LAS float* red = part + 512;
    __syncthreads();
    const float* sr = sraw + (size_t)sb * NHG + hh * 128;
    if (tid < 128) { const float q = sr[tid], f = sr[D + tid], x = sr[2 * D + tid]; const float l = lb[hh * 128 + tid]; const float k1 = (1.0f - l) * fast_rcp(1.0f + __expf(f));
        fk[tid] = 1.0f - k1; kk[tid] = k1; qv[tid] = siluf_(q) * 0.08838834764831845f; iv[tid] = x; }
    __syncthreads();
    const int v = tid & 127, kg = tid >> 7; const size_t base = ((size_t)(sb * 32 + hh) * 128 + kg * 32) * 128 + v; const float xi = iv[v]; float op = 0.f;
    float s0v[32];
#pragma unroll
    for (int k = 0; k < 32; ++k) s0v[k] = __builtin_nontemporal_load(st_in + base + (size_t)k * 128);
#pragma unroll
    for (int k = 0; k < 32; ++k) { const float s = fk[kg * 32 + k] * s0v[k] + kk[kg * 32 + k] * xi; __builtin_nontemporal_store(s, st_out + base + (size_t)k * 128); op += qv[kg * 32 + k] * s; }
    part[kg * 128 + v] = op;
    __syncthreads();
    float o = 0.f;
    if (tid < 128) { o = (part[tid] + part[128 + tid]) + (part[256 + tid] + part[384 + tid]); const float ws = wave_sum(o * o); if (lane == 0) red[wave] = ws; }
    __syncthreads();
    if (tid < 128) { const float rstd = __builtin_amdgcn_rsqf((red[0] + red[1]) * (1.0f / 128.0f) + RMS_EPS); const float g = sr[3 * D + tid];
        OG[(size_t)(MP + sb) * D + hh * 128 + tid] = (bf16)(pk2(o * rstd * nw[tid] * siluf_(g), 0.f) & 0xffffu); }
}

struct Args { const float* in[19]; float* out; unsigned char* ws; int ph_lo, ph_hi, li, pad; };
enum { I_XP = 0, I_XS, I_CK, I_CV, I_ST, I_NMIX, I_NFFN, I_NFIN, I_WQKV, I_BQKV, I_SINK, I_WO, I_BO, I_HWIN, I_HLB, I_HNORM, I_HWO, I_FWIN, I_FWOUT };

template <class Epi, bool I8 = false> __device__ __forceinline__ void run_gemm(LAS unsigned char* lds, const bf16* A, const bf16* Bt, int N, int K, const Epi& E, int Gn = (int)gridDim.x, int cn = (int)blockIdx.x, int nx = pg8::NXCD) {
    pg8::Gemm g{A, Bt, MP, N, K}; pg8::StaticOrder S; S.init(MP, N, Gn, cn, nx);
    pg8::gemm_phase<Epi, pg8::StaticOrder, true, true, I8>(lds, g, S, E);
}
__device__ __forceinline__ void sample_deal(int nwg, int& u0, int& ustep) { const int G = (int)gridDim.x, first = nwg % G; if (first == 0) { u0 = (int)blockIdx.x; ustep = G; } else { u0 = (int)blockIdx.x >= first ? (int)blockIdx.x - first : (1 << 30); ustep = G - first; } }
__device__ __forceinline__ void sample_res(LAS unsigned char* lds, const bf16* A, int K, const bf16* Bt, bf16* xb, float* out, const float* bias, ssq_t* ss, int tid, int wave, int lane) {
    const int row = tid >> 4, n = tid & 15;
    SampleA sa; const bool resident = (K == D) && (int)blockIdx.x < D / 16; if (resident) sample_load_a(sa, A, wave, lane);
    for (int u = blockIdx.x; u < D / 16; u += gridDim.x) { float r[1];
        if (K == D) sgemm_unit_ra<1>(sa, Bt + (size_t)u * 16 * K, Bt + (size_t)u * 16 * K, (LAS float*)lds, wave, lane, tid, r); else sgemm_unit<1>(A, K, Bt + (size_t)u * 16 * K, Bt + (size_t)u * 16 * K, (LAS float*)lds, wave, lane, tid, r);
        const int col = u * 16 + n; const size_t off = (size_t)row * D + col; float x = bf2f(xb[off]) + r[0] + (bias ? bias[col] : 0.f);
        if (out) out[off] = x; else { const bf16 xr = (bf16)(pk2(x, 0.f) & 0xffffu); xb[off] = xr; x = bf2f(xr); }
        float sq = x * x; sq += __shfl_xor(sq, 1); sq += __shfl_xor(sq, 2); sq += __shfl_xor(sq, 4); sq += __shfl_xor(sq, 8);
        if (n == 0) __hip_atomic_fetch_add(ss + row, ss_fix(sq), RLX_AGENT); }
}
__device__ __forceinline__ void sample_res_ksplit(LAS unsigned char* lds, volatile LAS unsigned* flagw, const bf16* A, const bf16* Bt, bf16* xb, ssq_t* ss, float* part, unsigned* cnt, int tid, int wave, int lane) {
    constexpr int KC = DFF / 8, NST = KC / 32;
    static_assert(KC * 8 == DFF && NST * 32 == KC, "K-chunks of whole 32-k steps");
    const int bx = (int)blockIdx.x, kc = bx & 7, nb = bx >> 3, fr = lane & 15, fq = lane >> 4;
    constexpr int NFW = (2 * NST + NWAVES - 1) / NWAVES; v4u af[NFW];
#pragma unroll
    for (int i = 0; i < NFW; ++i) { const int f = wave + i * NWAVES, fc = f < 2 * NST ? f : 0, t = fc >> 1, h = fc & 1;
        af[i] = *(const v4u*)(A + (size_t)(16 * h + fr) * DFF + kc * KC + t * 32 + fq * 8); }
    const bf16* bp = Bt + (size_t)(nb * 128 + wave * 16 + fr) * DFF + kc * KC + fq * 8;
    bf16x8 b[NST];
#pragma unroll
    for (int t = 0; t < NST / 2; ++t) b[t] = *(const bf16x8*)(bp + t * 32);
#pragma unroll
    for (int i = 0; i < NFW; ++i) { const int f = wave + i * NWAVES; if (f < 2 * NST) *(LAS v4u*)(lds + f * 1024 + lane * 16) = af[i]; }
#pragma unroll
    for (int t = NST / 2; t < NST; ++t) b[t] = *(const bf16x8*)(bp + t * 32);
    __syncthreads();
    f32x4 c0 = (f32x4){0.f, 0.f, 0.f, 0.f}, c1 = (f32x4){0.f, 0.f, 0.f, 0.f};
#pragma unroll
    for (int t = 0; t < NST; ++t) { const bf16x8 a0 = *(const LAS bf16x8*)(lds + (2 * t) * 1024 + lane * 16), a1 = *(const LAS bf16x8*)(lds + (2 * t + 1) * 1024 + lane * 16);
        c0 = MFMA16(b[t], a0, c0); c1 = MFMA16(b[t], a1, c1); }
    { float* pp = part + ((size_t)kc * MS + fr) * D + nb * 128 + wave * 16 + 4 * fq; *(f32x4*)pp = c0; *(f32x4*)(pp + (size_t)16 * D) = c1; }
    asm volatile("s_waitcnt vmcnt(0)" ::: "memory");
    __syncthreads();
    if (tid == 0) { __builtin_amdgcn_fence(__ATOMIC_RELEASE, "agent"); asm volatile("s_waitcnt vmcnt(0)" ::: "memory");
        const unsigned old = xb_add(cnt + nb, 1u); unsigned last = 0u;
        if (old == 7u) { __builtin_amdgcn_fence(__ATOMIC_ACQUIRE, "agent"); asm volatile("s_waitcnt vmcnt(0)" ::: "memory"); last = 1u; }
        *flagw = last; }
    __syncthreads();
    if (*flagw) {
        const int row = tid >> 4, c8 = nb * 128 + (tid & 15) * 8; f32x4 s0 = (f32x4){0.f, 0.f, 0.f, 0.f}, s1 = s0;
#pragma unroll
        for (int k = 0; k < 8; ++k) { const float* pp = part + ((size_t)k * MS + row) * D + c8; s0 += *(const f32x4*)pp; s1 += *(const f32x4*)(pp + 4); }
        const v4u xr = *(const v4u*)(xb + (size_t)row * D + c8); const unsigned xw_[4] = {xr.x, xr.y, xr.z, xr.w}; float o[8];
#pragma unroll
        for (int e = 0; e < 8; ++e) { const float xv = __builtin_bit_cast(float, (e & 1) ? (xw_[e >> 1] & 0xffff0000u) : (xw_[e >> 1] << 16)); o[e] = xv + (e < 4 ? s0[e & 3] : s1[e & 3]); }
        v4u w; w.x = pk2(o[0], o[1]); w.y = pk2(o[2], o[3]); w.z = pk2(o[4], o[5]); w.w = pk2(o[6], o[7]); *(v4u*)(xb + (size_t)row * D + c8) = w;
        const unsigned ww_[4] = {w.x, w.y, w.z, w.w}; float sq = 0.f;
#pragma unroll
        for (int e = 0; e < 8; ++e) { const float xv = __builtin_bit_cast(float, (e & 1) ? (ww_[e >> 1] & 0xffff0000u) : (ww_[e >> 1] << 16)); sq += xv * xv; }
        sq += __shfl_xor(sq, 1); sq += __shfl_xor(sq, 2); sq += __shfl_xor(sq, 4); sq += __shfl_xor(sq, 8);
        if ((tid & 15) == 0) __hip_atomic_fetch_add(ss + row, ss_fix(sq), RLX_AGENT);
    }
    __syncthreads();
}
#ifndef FFI_IDLE_UNITS
#define FFI_IDLE_UNITS 5
#endif
__device__ __forceinline__ void sample_ffn_in(LAS unsigned char* lds, const bf16* A, const bf16* Bt, bf16* H, const ssq_t* ss, int tid, int wave, int lane) {
    const int row = tid >> 4, n = tid & 15;
    const int Gs = (int)gridDim.x, first = ((MP / 256) * (NFI / 256)) % Gs, nidle = first ? Gs - first : 0, nfast = nidle * FFI_IDLE_UNITS < DFF / 16 ? nidle * FFI_IDLE_UNITS : 0;
    int su0, sus, suend;
    if (nfast && (int)blockIdx.x >= first) { su0 = (int)blockIdx.x - first; sus = nidle; suend = nfast; } else if (nfast) { su0 = nfast + (int)blockIdx.x; sus = first; suend = DFF / 16; } else { su0 = (int)blockIdx.x; sus = Gs; suend = DFF / 16; }
    SampleA sa; if (su0 < suend) sample_load_a(sa, A, wave, lane);
    for (int u = su0; u < suend; u += sus) { const int j0 = u * 16; const bf16* bg = Bt + (size_t)(256 * (j0 >> 7) + (j0 & 127)) * D; float r[2];
        sgemm_unit_ra<2>(sa, bg, bg + (size_t)128 * D, (LAS float*)lds, wave, lane, tid, r);
        const float rs = ss_rstd(ss, row); H[(size_t)row * DFF + j0 + n] = (bf16)(pk2(siluf_(r[0] * rs) * (r[1] * rs), 0.f) & 0xffffu); }
}

__device__ __forceinline__ void sample_ffn_in_q(LAS unsigned char* lds, const signed char* A8, const signed char* Bq, bf16* H, const float* ra, const float* bs, int tid, int wave, int lane) {
    const int row = tid >> 4, n = tid & 15;
    const int Gs = (int)gridDim.x, first = ((MP / 256) * (NFI / 256)) % Gs, nidle = first ? Gs - first : 0, nfast = nidle * FFI_IDLE_UNITS < DFF / 16 ? nidle * FFI_IDLE_UNITS : 0;
    int su0, sus, suend;
    if (nfast && (int)blockIdx.x >= first) { su0 = (int)blockIdx.x - first; sus = nidle; suend = nfast; } else if (nfast) { su0 = nfast + (int)blockIdx.x; sus = first; suend = DFF / 16; } else { su0 = (int)blockIdx.x; sus = Gs; suend = DFF / 16; }
    SampleA8 sa; if (su0 < suend) sample_load_a8(sa, A8, wave, lane);
    const float rs = ra[row];
    for (int u = su0; u < suend; u += sus) { const int j0 = u * 16, wr0 = 256 * (j0 >> 7) + (j0 & 127); const signed char* bg = Bq + (size_t)wr0 * D; float r[2];
        sgemm_unit_i8x2(sa, bg, bg + (size_t)128 * D, (LAS float*)lds, wave, lane, tid, r);
        H[(size_t)row * DFF + j0 + n] = (bf16)(pk2(siluf_(r[0] * (rs * bs[wr0 + n])) * (r[1] * (rs * bs[wr0 + 128 + n])), 0.f) & 0xffffu); }
}

#define PTR64(k) ({ const unsigned long long v_ = ptab[k]; ((unsigned long long)(unsigned)__builtin_amdgcn_readfirstlane((int)(v_ >> 32)) << 32) | (unsigned)__builtin_amdgcn_readfirstlane((int)v_); })
#define PIN(k) ((const float*)(const GAS float*)PTR64(k))
constexpr int CI0 = (D / 64) * (QKVN / 32), CI1 = (D / 64) * (D / 32), CI2 = (D / 64) * (NFI / 32), CI3 = (DFF / 64) * (D / 32), CI4 = (D / 64) * (NHG / 32);
constexpr int CO_WO = CI0, CO_FI0 = CO_WO + CI1, CO_FO0 = CO_FI0 + CI2, CO_HI = CO_FO0 + CI3, CO_HO = CO_HI + CI4, CO_FI1 = CO_HO + CI1, CO_FO1 = CO_FI1 + CI2, CO_END = CO_FO1 + CI3;
__device__ __forceinline__ CvItem cv_lookup(volatile LAS unsigned long long* ptab, int it) {
    unsigned char* ws = (unsigned char*)(GAS unsigned char*)PTR64(20); CvItem c; int r = it;
    if (r < CO_WO)       { c.W = PIN(I_WQKV); c.K = D; c.N = QKVN; c.WT = (bf16*)(ws + WS_WQKV); c.map = 0; c.kw = PIN(I_NMIX); }
    else if (r < CO_FI0) { r -= CO_WO;  c.W = PIN(I_WO); c.K = D; c.N = D; c.WT = (bf16*)(ws + WS_WO); c.map = 0; c.kw = nullptr; }
    else if (r < CO_FO0) { r -= CO_FI0; c.W = PIN(I_FWIN); c.K = D; c.N = NFI; c.WT = (bf16*)(ws + WS_WFI0); c.map = 1; c.kw = PIN(I_NFFN); }
    else if (r < CO_HI)  { r -= CO_FO0; c.W = PIN(I_FWOUT); c.K = DFF; c.N = D; c.WT = (bf16*)(ws + WS_WFO0); c.map = 0; c.kw = nullptr; }
    else if (r < CO_HO)  { r -= CO_HI;  c.W = PIN(I_HWIN); c.K = D; c.N = NHG; c.WT = (bf16*)(ws + WS_WHI); c.map = 2; c.kw = PIN(I_NMIX) + D; }
    else if (r < CO_FI1) { r -= CO_HO;  c.W = PIN(I_HWO); c.K = D; c.N = D; c.WT = (bf16*)(ws + WS_WHO); c.map = 0; c.kw = nullptr; }
    else if (r < CO_FO1) { r -= CO_FI1; c.W = PIN(I_FWIN) + (size_t)D * NFI; c.K = D; c.N = NFI; c.WT = (bf16*)(ws + WS_WFI1); c.map = 1; c.kw = PIN(I_NFFN) + D; }
    else                 { r -= CO_FO1; c.W = PIN(I_FWOUT) + (size_t)DFF * D; c.K = DFF; c.N = D; c.WT = (bf16*)(ws + WS_WFO1); c.map = 0; c.kw = nullptr; }
    c.item = r; return c;
}
__device__ __forceinline__ void convert_items(volatile LAS unsigned long long* ptab, int lo, int hi, int worker, int nworkers, LAS float* scr, int lane) {
    for (int it = lo + worker; it < hi; it += 2 * nworkers) {
        const bool two = it + nworkers < hi;
        const CvItem ca = cv_lookup(ptab, it), cb = cv_lookup(ptab, two ? it + nworkers : it);
        float va[32], vb[32], ka, kb_;
        cv_load(ca, lane, va, ka);
        if (two) cv_load(cb, lane, vb, kb_);
        cv_store(ca, lane, va, ka, scr);
        if (two) cv_store(cb, lane, vb, kb_, scr);
    }
}
#ifndef CV_S7
#define CV_S7 8192
#endif
constexpr int S7_LO = CO_HO, S7_HI = CO_HO + CV_S7;
static_assert(S7_HI <= CO_FO1, "the P7 slot holds only weights that are first used after P7");
#ifndef CV_SPLIT
#define CV_SPLIT CO_WO
#endif
static_assert(CV_SPLIT >= CO_WO && (CV_SPLIT <= S7_LO || CV_SPLIT >= S7_HI), "P0 converts items [0, CV_SPLIT), P1's conversion half the rest");

__global__ void __launch_bounds__(NWAVES * 64, 2) fwd_kernel(Args args) {
    extern __shared__ __attribute__((aligned(16))) unsigned char lds_raw[];
    LAS unsigned char* lds = (LAS unsigned char*)lds_raw;
    volatile LAS unsigned* MISC = (volatile LAS unsigned*)(lds + MISC_OFF);
    const int tid = threadIdx.x, lane = tid & 63, wave = __builtin_amdgcn_readfirstlane(tid >> 6);
    const int G = gridDim.x; const int bx = blockIdx.x; const int vcu = (G % 8 == 0) ? (bx % 8) * (G / 8) + bx / 8 : bx;
    unsigned char* ws = args.ws;
    gu32* ctl = (gu32*)(ws + WS_CTL);
    for (int u = tid; u < (LDS_BYTES - LDSCTL_OFF) / 4; u += NWAVES * 64) ((LAS unsigned*)(lds + LDSCTL_OFF))[u] = 0u;
    __syncthreads();
    volatile LAS unsigned long long* ptab = (volatile LAS unsigned long long*)(lds + PTAB_OFF);
    if (tid == 0) {
#pragma unroll
        for (int k = 0; k < 19; ++k) ptab[k] = (unsigned long long)args.in[k];
        ptab[19] = (unsigned long long)args.out; ptab[20] = (unsigned long long)args.ws; }
    __syncthreads();
    XcdBarrier bar; bar.bar = (unsigned*)(ctl + CW_BAR); bar.x = 0; bar.st = nullptr;
    if (N_LAUNCHES == 1) bar = xcd_barrier_post((unsigned*)(ctl + CW_BAR), MISC + 8);
#define GRID_BAR() do { if (N_LAUNCHES == 1) xcd_barrier(bar); } while (0)
    const int lo = args.ph_lo, hi = args.ph_hi;
#ifdef ONLY_PHASE
#define IN(k) ((k) == ONLY_PHASE && lo <= (k) && (k) < hi)
#else
#define IN(k) (lo <= (k) && (k) < hi)
#endif
#define BOTH(k) (IN(k) && IN((k) + 1))
#ifndef REPMASK
#define REPMASK 0
#endif
#ifndef REPN
#define REPN 1
#endif
#define REPEAT(k) for (int rep_ = 0; rep_ < (((REPMASK) >> (k)) & 1) * (REPN) + 1; ++rep_)
#define WSB ((unsigned char*)(GAS unsigned char*)PTR64(20))
#define WQKV ((bf16*)(WSB + WS_WQKV))
#define WO ((bf16*)(WSB + WS_WO))
#define WFI0 ((bf16*)(WSB + WS_WFI0))
#define WFO0 ((bf16*)(WSB + WS_WFO0))
#define WHI ((bf16*)(WSB + WS_WHI))
#define WHO ((bf16*)(WSB + WS_WHO))
#define WFI1 ((bf16*)(WSB + WS_WFI1))
#define WFO1 ((bf16*)(WSB + WS_WFO1))
#define XB ((bf16*)(WSB + WS_XN))
#define Qb ((bf16*)(WSB + WS_Q))
#define Kb ((bf16*)(WSB + WS_K))
#define Vb ((bf16*)(WSB + WS_V))
#define Ob ((bf16*)(WSB + WS_O))
#define Hb ((bf16*)(WSB + WS_H))
#define QT ((bf16*)(WSB + WS_QT))
#define KT ((bf16*)(WSB + WS_KT))
#define KP ((bf16*)(WSB + WS_KP))
#define VI ((bf16*)(WSB + WS_VI))
#define GSb ((bf16*)(WSB + WS_GS))
#define DEC ((float*)(WSB + WS_DEC))
#define SRAW ((float*)(WSB + WS_SRAW))
#define LB ((float*)(WSB + WS_LB))
#define XQ ((signed char*)(WSB + WS_XQ))
#define XQS ((signed char*)(WSB + WS_RA + 65536))
#define RA ((float*)(WSB + WS_RA))
#define WQ1 ((signed char*)(WSB + WS_WQ1))
#define BSC ((float*)(WSB + WS_BSC))
#define WQ0 ((signed char*)(WSB + WS_WQ0))
#define WQO ((signed char*)(WSB + WS_WQO))
#define WQQ ((signed char*)(WSB + WS_WQQ))
#define BSCQ ((float*)(WSB + WS_BSCQ))
#define BSCO ((float*)(WSB + WS_BSCO))
#define BSC0 ((float*)(WSB + WS_BSC0))
#define SSB(k) ((ssq_t*)(WSB + WS_CTL + CW_SS * 4) + (k) * SS_STRIDE)
#define SS0 SSB(0)
#define SS1 SSB(1)
#define SS2 SSB(2)
#define SS3 SSB(3)
#define SS4 SSB(4)
#define out ((float*)(GAS float*)PTR64(19))

    if (IN(0)) REPEAT(0) {
        LAS float* scr = (LAS float*)(lds + RING_OFF + wave * 16384);
        const int gw = vcu * NWAVES + wave, NGW = G * NWAVES;
        convert_items(ptab, 0, CV_SPLIT < S7_LO ? CV_SPLIT : S7_LO, gw, NGW, scr, lane);
        if (CV_SPLIT > S7_HI) convert_items(ptab, S7_HI, CV_SPLIT, gw, NGW, scr, lane);
        for (int m = gw; m < MT; m += NGW) row_to_bf16_ss(m < MP ? PIN(I_XP) + (size_t)m * D : PIN(I_XS) + (size_t)(m - MP) * D, XB + (size_t)m * D, SS0 + m, lane, m < MP ? XQ + (size_t)m * D : nullptr, RA + (m < MP ? m : 0));
        if (bx == 0) for (int c = tid; c < D; c += NWAVES * 64) LB[c] = fast_rcp(1.0f + __expf(PIN(I_HLB)[c] - PIN(I_HLB)[D + c]));
        if (BOTH(0)) GRID_BAR();
    }
    if (IN(1)) REPEAT(1) {
        const int GH = G / 2; const bool gemm_side = (bx & 1) == 0; const int hidx = ((bx & 7) >> 1) + 4 * (bx >> 3);
        if (gemm_side) {
            unsigned* sideA = (unsigned*)(ctl + CW_SIDE_A); unsigned* tmo = (unsigned*)(ctl + CW_BAR) + XB_TMO;
            quant_rows_i8(hidx * NWAVES + wave, D, GH * NWAVES, lane, [&](int r, const bf16*& sp, signed char*& dp, float*& sc, float& ex) { sp = WQKV + (size_t)r * D; dp = WQQ + (size_t)r * D; sc = BSCQ + r; ex = 1.0f; });
            side_barrier(sideA, GH, tmo);
            { EpiQKVT<true> E{Qb, Kb, Vb, PIN(I_BQKV), out + OUT_WKP, out + OUT_WVP, SS0, RA, BSCQ, 0}; run_gemm<EpiQKVT<true>, true>(lds + RING_OFF, (const bf16*)XQ, (const bf16*)WQQ, D, D / 2, E, GH, hidx, 4); }
            { EpiQKVT<false> E{Qb, Kb, Vb, PIN(I_BQKV), out + OUT_WKP, out + OUT_WVP, SS0, nullptr, nullptr, 16}; run_gemm(lds + RING_OFF, XB, WQKV + (size_t)D * D, 2 * KVD, D, E, GH, hidx, 4); }
            const int row = tid >> 4, n = tid & 15;
            SampleA sa; if (hidx < QKVN / 16) sample_load_a(sa, XB + (size_t)MP * D, wave, lane);
            for (int u = hidx; u < QKVN / 16; u += GH) { float r[1]; sgemm_unit_ra<1>(sa, WQKV + (size_t)u * 16 * D, WQKV + (size_t)u * 16 * D, (LAS float*)lds, wave, lane, tid, r);
                const int col = u * 16 + n; const float v = r[0] * ss_rstd(SS0, MP + row) + PIN(I_BQKV)[col]; const bf16 vb = (bf16)(pk2(v, 0.f) & 0xffffu);
                if (col < D) Qb[(size_t)(MP + row) * D + col] = vb;
                else if (col < D + KVD) { Kb[(size_t)(MP + row) * KVD + col - D] = vb; out[OUT_WKS + ((size_t)row * 128 + 127) * KVD + col - D] = v; }
                else { Vb[(size_t)(MP + row) * KVD + col - D - KVD] = vb; out[OUT_WVS + ((size_t)row * 128 + 127) * KVD + col - D - KVD] = v; } }
            side_barrier(sideA, 2 * GH, tmo);
            { AttnKV kv; if (hidx < NBATCH * 16 * 8) attn_kv_load(kv, Kb, Vb, hidx >> 7, hidx & 7, (hidx >> 3) & 15, tid);
              for (int u = hidx; u < NBATCH * 16 * 8; u += GH) { const int hkv = u & 7, n = (u >> 3) & 15, b = u >> 7; const int un = u + GH; const bool hn = un < NBATCH * 16 * 8;
                  attn_prompt_unit(lds + RING_OFF, Qb, Kb, Vb, Ob, PIN(I_SINK), b, hkv, n, kv, hn, un >> 7, un & 7, (un >> 3) & 15, tid, wave, lane); } }
            for (int u = hidx; u < MS * 8; u += GH) attn_sample_unit(lds + RING_OFF, Qb, Kb, Vb, Ob, PIN(I_SINK), PIN(I_CK), PIN(I_CV), out + OUT_WKS, out + OUT_WVS, u >> 3, u & 7, tid, wave, lane);
            side_barrier(sideA, 3 * GH, tmo);
            quant_rows_i8(hidx * NWAVES + wave, MP, GH * NWAVES, lane, [&](int r, const bf16*& sp, signed char*& dp, float*& sc, float& ex) { sp = Ob + (size_t)r * D; dp = XQ + (size_t)r * D; sc = RA + r; ex = 1.0f; });
        } else {
            LAS float* scr = (LAS float*)(lds + RING_OFF + wave * 16384); const int wk = hidx * NWAVES + wave, nwk = (G - GH) * NWAVES;
            if (CV_SPLIT < S7_LO) convert_items(ptab, CV_SPLIT, S7_LO, wk, nwk, scr, lane);
            convert_items(ptab, CV_SPLIT > S7_HI ? CV_SPLIT : S7_HI, CO_END, wk, nwk, scr, lane);
        }
        if (BOTH(1)) GRID_BAR();
    }
    if (IN(2)) REPEAT(2) {
        quant_rows_i8(vcu * NWAVES + wave, NFI, G * NWAVES, lane, [&](int r, const bf16*& sp, signed char*& dp, float*& sc, float& ex) { sp = WFI0 + (size_t)r * D; dp = WQ0 + (size_t)r * D; sc = BSC0 + r; ex = 1.0f; });
        quant_rows_i8(vcu * NWAVES + wave, D, G * NWAVES, lane, [&](int r, const bf16*& sp, signed char*& dp, float*& sc, float& ex) { sp = WO + (size_t)r * D; dp = WQO + (size_t)r * D; sc = BSCO + r; ex = 1.0f; });
        __syncthreads();
        if (BOTH(2)) GRID_BAR();
    }
    if (IN(3)) {
        { EpiResT<true> E{XB, nullptr, PIN(I_BO), SS1, RA, BSCO}; run_gemm<EpiResT<true>, true>(lds + RING_OFF, (const bf16*)XQ, (const bf16*)WQO, D, D / 2, E); }
        sample_res(lds + RING_OFF, Ob + (size_t)MP * D, D, WO, XB + (size_t)MP * D, nullptr, PIN(I_BO), SS1 + MP, tid, wave, lane);
        if (BOTH(3)) GRID_BAR();
    }
    if (IN(4)) REPEAT(4) {
        quant_rows_i8(vcu * NWAVES + wave, MT, G * NWAVES, lane, [&](int r, const bf16*& sp, signed char*& dp, float*& sc, float& ex) { sp = XB + (size_t)r * D; dp = r < MP ? XQ + (size_t)r * D : XQS + (size_t)(r - MP) * D; sc = RA + r; ex = ss_rstd(SS1, r); });
        GRID_BAR();
        { EpiSwiGLUQ E{Hb, RA, BSC0}; run_gemm<EpiSwiGLUQ, true>(lds + RING_OFF, (const bf16*)XQ, (const bf16*)WQ0, NFI, D / 2, E); }
        sample_ffn_in_q(lds + RING_OFF, XQS, WQ0, Hb + (size_t)MP * DFF, RA + MP, BSC0, tid, wave, lane);
        if (BOTH(4)) GRID_BAR();
    }
    if (IN(5)) {
        { EpiRes E{XB, nullptr, nullptr, SS2}; run_gemm(lds + RING_OFF, Hb, WFO0, D, DFF, E); }
        if (G == 256) sample_res_ksplit(lds + RING_OFF, MISC + 12, Hb + (size_t)MP * DFF, WFO0, XB + (size_t)MP * D, SS2 + MP, (float*)(WSB + WS_PART), (unsigned*)(ctl + CW_SRES), tid, wave, lane);
        else sample_res(lds + RING_OFF, Hb + (size_t)MP * DFF, DFF, WFO0, XB + (size_t)MP * D, nullptr, nullptr, SS2 + MP, tid, wave, lane);
        if (BOTH(5)) GRID_BAR();
    }
    if (IN(6)) REPEAT(6) {
        { EpiHgrnIn E{QT, KT, VI, GSb, DEC, LB, SS2}; run_gemm(lds + RING_OFF, XB, WHI, NHG, D, E); }
        const int row = tid >> 4, n = tid & 15;
        SampleA sa; sample_load_a(sa, XB + (size_t)MP * D, wave, lane);
        for (int u = bx; u < NHG / 16; u += G) { float r[1]; sgemm_unit_ra<1>(sa, WHI + (size_t)u * 16 * D, WHI + (size_t)u * 16 * D, (LAS float*)lds, wave, lane, tid, r);
            const int R = u * 16, tile = R >> 8, w = R & 255; const int c0 = ((tile & 4) ? 2 * D : 0) + (w < 128 ? 0 : D) + (4 * (tile >> 3) + (tile & 3)) * 128 + (w & 127);
            const float rs = ss_rstd(SS2, MP + row); SRAW[(size_t)row * NHG + c0 + n] = r[0] * rs; }
        if (BOTH(6)) GRID_BAR();
    }
    if (IN(7)) REPEAT(7) {
        const int nseq = NBATCH * 32; const int half = G >= 2 * nseq ? nseq : 0;
        if (bx < nseq || half == 0) { for (int u = bx; u < nseq; u += (half ? nseq : G)) gla_prompt_seq(lds + RING_OFF, QT, KT, VI, GSb, DEC, PIN(I_HNORM), Ob, out + OUT_STP, u >> 5, u & 31, tid, wave, lane); }
        if (bx >= half) { for (int u = bx - half; u < MS * 32; u += G - half) gla_sample_unit(lds + RING_OFF, SRAW, PIN(I_ST), LB, PIN(I_HNORM), Ob, out + OUT_STS, u >> 5, u & 31, tid, wave, lane);
            if (half) { __syncthreads(); convert_items(ptab, S7_LO, S7_HI, (bx - half) * NWAVES + wave, (G - half) * NWAVES, (LAS float*)(lds + RING_OFF + wave * 16384), lane); }
            quant_rows_i8((bx - half) * NWAVES + wave, NFI, (G - half) * NWAVES, lane, [&](int r, const bf16*& sp, signed char*& dp, float*& sc, float& ex) { sp = WFI1 + (size_t)r * D; dp = WQ1 + (size_t)r * D; sc = BSC + r; ex = 1.0f; }); }
        __syncthreads();
        if (BOTH(7)) GRID_BAR();
    }
    if (IN(8)) {
        { EpiRes E{XB, nullptr, nullptr, SS3}; run_gemm(lds + RING_OFF, Ob, WHO, D, D, E); }
        sample_res(lds + RING_OFF, Ob + (size_t)MP * D, D, WHO, XB + (size_t)MP * D, nullptr, nullptr, SS3 + MP, tid, wave, lane);
        if (BOTH(8)) GRID_BAR();
    }
    if (IN(9)) REPEAT(9) {
        quant_rows_i8(vcu * NWAVES + wave, MT, G * NWAVES, lane, [&](int r, const bf16*& sp, signed char*& dp, float*& sc, float& ex) { sp = XB + (size_t)r * D; dp = r < MP ? XQ + (size_t)r * D : XQS + (size_t)(r - MP) * D; sc = RA + r; ex = ss_rstd(SS3, r); });
        GRID_BAR();
        { EpiSwiGLUQ E{Hb, RA, BSC}; run_gemm<EpiSwiGLUQ, true>(lds + RING_OFF, (const bf16*)XQ, (const bf16*)WQ1, NFI, D / 2, E); }
        sample_ffn_in_q(lds + RING_OFF, XQS, WQ1, Hb + (size_t)MP * DFF, RA + MP, BSC, tid, wave, lane);
        if (BOTH(9)) GRID_BAR();
    }
    if (IN(10)) {
        { EpiRes E{XB, nullptr, nullptr, SS4}; run_gemm(lds + RING_OFF, Hb, WFO1, D, DFF, E); }
        if (G == 256) sample_res_ksplit(lds + RING_OFF, MISC + 12, Hb + (size_t)MP * DFF, WFO1, XB + (size_t)MP * D, SS4 + MP, (float*)(WSB + WS_PART), (unsigned*)(ctl + CW_SRES) + 32, tid, wave, lane);
        else sample_res(lds + RING_OFF, Hb + (size_t)MP * DFF, DFF, WFO1, XB + (size_t)MP * D, nullptr, nullptr, SS4 + MP, tid, wave, lane);
        if (BOTH(10)) GRID_BAR();
    }
    if (IN(11)) {
        const float* nf = PIN(I_NFIN); const ssq_t* s3 = SS4;
        const size_t NPC = (size_t)MT * D / 8, stride = (size_t)G * NWAVES * 64; size_t i = (size_t)vcu * (NWAVES * 64) + tid;
        const int c8 = tid & 511; const f32x4 w0 = ((const f32x4*)nf)[2 * c8], w1 = ((const f32x4*)nf)[2 * c8 + 1];
        auto fin = [&](size_t ii, v4u x, float rs) {
            f32x4 y0, y1; y0[0] = __builtin_bit_cast(float, x.x << 16); y0[1] = __builtin_bit_cast(float, x.x & 0xffff0000u); y0[2] = __builtin_bit_cast(float, x.y << 16); y0[3] = __builtin_bit_cast(float, x.y & 0xffff0000u);
            y1[0] = __builtin_bit_cast(float, x.z << 16); y1[1] = __builtin_bit_cast(float, x.z & 0xffff0000u); y1[2] = __builtin_bit_cast(float, x.w << 16); y1[3] = __builtin_bit_cast(float, x.w & 0xffff0000u);
            __builtin_nontemporal_store(y0 * rs * w0, (GAS f32x4*)(out + OUT_Y) + 2 * ii); __builtin_nontemporal_store(y1 * rs * w1, (GAS f32x4*)(out + OUT_Y) + 2 * ii + 1); };
        for (; i + 3 * stride < NPC; i += 4 * stride) { v4u x[4]; float rs[4];
#pragma unroll
            for (int q = 0; q < 4; ++q) { const size_t ii = i + q * stride; x[q] = ((const v4u*)XB)[ii]; rs[q] = ss_rstd(s3, (int)(ii >> 9)); }
#pragma unroll
            for (int q = 0; q < 4; ++q) fin(i + q * stride, x[q], rs[q]); }
        for (; i < NPC; i += stride) fin(i, ((const v4u*)XB)[i], ss_rstd(s3, (int)(i >> 9)));
    }
#undef IN
#undef BOTH
#undef GRID_BAR
#undef out
#undef WSB
#undef XQ
#undef XQS
#undef RA
#undef WQ1
#undef BSC
#undef WQ0
#undef WQO
#undef WQQ
#undef BSCQ
#undef BSCO
#undef BSC0
#undef WQKV
#undef WO
#undef WFI0
#undef WFO0
#undef WHI
#undef WHO
#undef WFI1
#undef WFO1
#undef XB
#undef Qb
#undef Kb
#undef Vb
#undef Ob
#undef Hb
#undef QT
#undef KT
#undef KP
#undef VI
#undef GSb
#undef DEC
#undef SRAW
#undef LB
#undef SSB
#undef SS0
#undef SS1
#undef SS2
#undef SS3
#undef SS4
}

extern "C" void kernel_launch(void* const* d_in, const int* in_sizes, int n_in, void* d_out, int out_size, void* d_ws, size_t ws_size, hipStream_t stream) {
    static int grid = 0;
    if (grid == 0) {
        if (n_in != 19 || (size_t)out_size != OUT_END || ws_size < WS_END) { fprintf(stderr, "kernel_launch: unexpected shapes (n_in %d, out %d, ws %zu); nothing launched\n", n_in, out_size, ws_size); grid = -1; return; }
        int dev = 0, cus = 0, per_cu = 0;
        if (hipGetDevice(&dev) != hipSuccess || hipDeviceGetAttribute(&cus, hipDeviceAttributeMultiprocessorCount, dev) != hipSuccess) { grid = -1; return; }
        if (hipFuncSetAttribute((const void*)fwd_kernel, hipFuncAttributeMaxDynamicSharedMemorySize, LDS_BYTES) != hipSuccess) { fprintf(stderr, "kernel_launch: hipFuncSetAttribute failed\n"); grid = -1; return; }
        if (hipOccupancyMaxActiveBlocksPerMultiprocessor(&per_cu, (const void*)fwd_kernel, NWAVES * 64, LDS_BYTES) != hipSuccess || per_cu < 1) { fprintf(stderr, "kernel_launch: occupancy query says %d blocks per CU\n", per_cu); }
        (void)hipGetLastError();
        grid = cus;
    }
    if (grid < 0) return;
    if (hipMemsetAsync((char*)d_ws + WS_CTL, 0, CTL_ZERO_BYTES, stream) != hipSuccess) { fprintf(stderr, "kernel_launch: memset failed\n"); return; }
    Args a{};
    for (int i = 0; i < 19; ++i) a.in[i] = (const float*)d_in[i];
    a.out = (float*)d_out; a.ws = (unsigned char*)d_ws;
    for (int li = 0; li < N_LAUNCHES; ++li) {
        a.ph_lo = (N_LAUNCHES == 1) ? 0 : li; a.ph_hi = (N_LAUNCHES == 1) ? NPHASE : li + 1; a.li = li; a.pad = 0;
        hipLaunchKernelGGL(fwd_kernel, dim3(grid), dim3(NWAVES * 64), LDS_BYTES, stream, a);
        const hipError_t le = hipPeekAtLastError();
        if (le != hipSuccess) { fprintf(stderr, "kernel_launch: launch %d failed: %s\n", li, hipGetErrorName(le)); break; }
    }
#ifdef EXTRA_PHASES
    { const int extra[] = {EXTRA_PHASES}; for (int e : extra) { a.ph_lo = e; a.ph_hi = e + 1; a.li = 1; hipLaunchKernelGGL(fwd_kernel, dim3(grid), dim3(NWAVES * 64), LDS_BYTES, stream, a); } }
#endif
#ifdef EXTRA_PHASES
    { const int extra[] = {EXTRA_PHASES}; for (int e : extra) { a.ph_lo = e; a.ph_hi = e + 1; a.li = 1; hipLaunchKernelGGL(fwd_kernel, dim3(grid), dim3(NWAVES * 64), LDS_BYTES, stream, a); } }
#endif
}
```

```cpp
#include <hip/hip_runtime.h>
#include <cstdio>
#include <cstdint>
namespace pg8 {
#define PG8_LAS __attribute__((address_space(3)))
typedef unsigned short bf16_t;
typedef short bf16x8 __attribute__((ext_vector_type(8)));
typedef float f32x4 __attribute__((ext_vector_type(4)));
typedef unsigned u32x4 __attribute__((ext_vector_type(4)));
constexpr int BM = 256, BK = 64, HALF = 128, HTB = HALF * BK * 2  , STAGE_BYTES = 8 * HTB, NXCD = 8, WGM = 8;

__host__ __device__ __forceinline__ int lds_byte(int r, int c) { const int st = (r >> 4) * 2 + (c >> 5), rr = r & 15, cc = c & 31, ob = rr * 64 + cc * 2; return st * 1024 + (ob ^ (((ob >> 9) & 1) << 5)); }
__host__ __device__ __forceinline__ void stage_rc(int b, int& R, int& C) { const int st = b / 1024, sb = b % 1024, swz = sb ^ (((sb >> 9) & 1) << 5); R = (st >> 1) * 16 + swz / 64; C = (st & 1) * 32 + (swz % 64) / 2; }
__host__ __device__ __forceinline__ int perm32(int rho) { const int n = rho >> 4, i = rho & 15; return 8 * (i >> 2) + 4 * n + (i & 3); }

struct Unit { int pm, pn; };
struct Gemm { const bf16_t* A; const bf16_t* Bt; int M, N, K; };

struct StaticOrder {
    int nM, nN, nwg, G, c, nx;
    __host__ __device__ void init(int M, int N, int G_, int c_, int nx_ = NXCD) { nM = M / BM; nN = N / BM; nwg = nM * nN; G = G_; c = c_; nx = nx_; }
    __host__ __device__ bool next(int i, Unit& u) const {
        const long L = (long)i * G + c; if (L >= nwg) return false;
        int wgid = (int)L; { const int q = nwg / nx, r = nwg % nx, xcd = wgid % nx, off = wgid / nx; wgid = (xcd < r ? xcd * (q + 1) : r * (q + 1) + (xcd - r) * q) + off; }
        const int nig = WGM * nN, gid = wgid / nig, fm = gid * WGM, gsz = (nM - fm) < WGM ? (nM - fm) : WGM;
        u.pm = fm + ((wgid % nig) % gsz); u.pn = (wgid % nig) / gsz; return true;
    }
    __device__ __forceinline__ void a_ready(const Unit&) const {}
    __device__ __forceinline__ void done(const Unit&) const {}
};
__device__ __forceinline__ unsigned cvt_pk_bf16(float lo, float hi) { unsigned r; asm volatile("v_cvt_pk_bf16_f32 %0, %1, %2" : "=v"(r) : "v"(lo), "v"(hi)); return r; }
typedef int i32x4 __attribute__((ext_vector_type(4)));
template <bool I8> __device__ __forceinline__ f32x4 mma16(bf16x8 b, bf16x8 a, f32x4 c) {
    if constexpr (I8) return __builtin_bit_cast(f32x4, __builtin_amdgcn_mfma_i32_16x16x64_i8(__builtin_bit_cast(i32x4, b), __builtin_bit_cast(i32x4, a), __builtin_bit_cast(i32x4, c), 0, 0, 0));
    else return __builtin_amdgcn_mfma_f32_16x16x32_bf16(b, a, c, 0, 0, 0);
}
template <class Epi, class Sched, bool ALIGN_EPI = false, bool SP2 = false, bool I8 = false>
__device__ __forceinline__ void gemm_phase(PG8_LAS unsigned char* lds, const Gemm g, const Sched& S, const Epi& E) {
    const int tid = threadIdx.x, wid = __builtin_amdgcn_readfirstlane(tid >> 6), lane = tid & 63, wr = wid >> 2, wc = wid & 3, fr = lane & 15, fq = lane >> 4;
    const int K = g.K, nt = K / BK;
    unsigned voffA[2], voffB[2];
#pragma unroll
    for (int i = 0; i < 2; ++i) { int R, C; stage_rc(tid * 16 + i * 8192, R, C); const int Rb = Epi::PERM ? ((R & ~31) + perm32(R & 31)) : R;
        voffA[i] = (unsigned)(R * K + C) * 2u; voffB[i] = (unsigned)(Rb * K + C) * 2u; }
    const size_t kstep = (size_t)(BK * 2);
    const size_t hstep = (size_t)HALF * K * 2;
    const size_t tstep = 2 * hstep;
    const unsigned ldsw = (unsigned)wid * 1024u;
    const int aoff = lds_byte(wr * 64 + fr, fq * 8), boff = lds_byte(wc * 32 + fr, fq * 8);
#define PG8_SA(b, h) (((b) * 2 + (h)) * HTB)
#define PG8_SB(b, h) ((4 + (b) * 2 + (h)) * HTB)
#define PG8_STAGE(bufoff, gbase, voff) do { _Pragma("unroll") for (int _i = 0; _i < 2; ++_i) \
        __builtin_amdgcn_global_load_lds((const unsigned*)((const char*)(gbase) + (voff)[_i]), (PG8_LAS unsigned*)(lds + (bufoff) + ldsw + _i * 8192), 16, 0, 0); } while (0)
#define PG8_LDA(dst, b, h) do { _Pragma("unroll") for (int m = 0; m < 4; ++m) _Pragma("unroll") for (int k = 0; k < 2; ++k) dst[m][k] = *(const PG8_LAS bf16x8*)(lds + PG8_SA(b, h) + aoff + m * 2048 + k * 1024); } while (0)
#define PG8_LDB(dst, b, h) do { _Pragma("unroll") for (int n = 0; n < 2; ++n) _Pragma("unroll") for (int k = 0; k < 2; ++k) dst[n][k] = *(const PG8_LAS bf16x8*)(lds + PG8_SB(b, h) + boff + n * 2048 + k * 1024); } while (0)
#define PG8_MMA(ai, bj, At, Bt) do { __builtin_amdgcn_s_setprio(1); _Pragma("unroll") for (int m = 0; m < 4; ++m) _Pragma("unroll") for (int n = 0; n < 2; ++n) _Pragma("unroll") for (int k = 0; k < 2; ++k) \
        acc[ai][bj][m][n] = mma16<I8>(Bt[n][k], At[m][k], acc[ai][bj][m][n]); __builtin_amdgcn_s_setprio(0); } while (0)
#define PG8_WAIT_V(n) asm volatile("s_waitcnt vmcnt(" #n ")" ::: "memory")
#define PG8_WAIT_L(n) asm volatile("s_waitcnt lgkmcnt(" #n ")" ::: "memory")
#define PG8_BAR __builtin_amdgcn_s_barrier()
#define PG8_SCHED __builtin_amdgcn_sched_barrier(0)
    Unit cur, nxt; int ui = 0;
    if (!S.next(0, cur)) return;
    f32x4 acc[2][2][4][2];
#pragma unroll
    for (int a = 0; a < 2; ++a)
#pragma unroll
        for (int b = 0; b < 2; ++b)
#pragma unroll
            for (int m = 0; m < 4; ++m)
#pragma unroll
                for (int n = 0; n < 2; ++n) acc[a][b][m][n] = (f32x4){0.f, 0.f, 0.f, 0.f};
    bf16x8 At[4][2], B0[2][2], B1[2][2];
    const char* cA = (const char*)g.A + (size_t)cur.pm * tstep; const char* cB = (const char*)g.Bt + (size_t)cur.pn * tstep;
    S.a_ready(cur);
    if constexpr (SP2) {
        PG8_STAGE(PG8_SB(0, 0), cB, voffB); PG8_STAGE(PG8_SB(0, 1), cB + hstep, voffB); PG8_STAGE(PG8_SA(0, 0), cA, voffA); PG8_STAGE(PG8_SA(0, 1), cA + hstep, voffA);
        if (wr == 1) PG8_BAR;
        PG8_WAIT_V(2); PG8_BAR;
        PG8_STAGE(PG8_SB(1, 0), cB + kstep, voffB); PG8_STAGE(PG8_SA(1, 0), cA + kstep, voffA); PG8_STAGE(PG8_SB(1, 1), cB + hstep + kstep, voffB);
        PG8_WAIT_V(6); PG8_BAR;
    } else {
        PG8_STAGE(PG8_SB(0, 0), cB, voffB); PG8_STAGE(PG8_SA(0, 0), cA, voffA); PG8_STAGE(PG8_SB(0, 1), cB + hstep, voffB); PG8_STAGE(PG8_SA(0, 1), cA + hstep, voffA);
        if (wr == 1) PG8_BAR;
        PG8_WAIT_V(4); PG8_BAR;
        PG8_STAGE(PG8_SB(1, 0), cB + kstep, voffB); PG8_STAGE(PG8_SA(1, 0), cA + kstep, voffA); PG8_STAGE(PG8_SB(1, 1), cB + hstep + kstep, voffB);
        PG8_WAIT_V(6); PG8_BAR;
    }
    for (;;) {
        const bool has_next = S.next(ui + 1, nxt);
        const char* nA = has_next ? (const char*)g.A + (size_t)nxt.pm * tstep : cA; const char* nB = has_next ? (const char*)g.Bt + (size_t)nxt.pn * tstep : cB;
        for (int t = 0; t < nt; t += 2) {
            const bool last = (t == nt - 2);
            const char* a1 = cA + (size_t)(t + 1) * kstep;
            const char* a2 = last ? nA : cA + (size_t)(t + 2) * kstep; const char* b2 = last ? nB : cB + (size_t)(t + 2) * kstep;
            const char* a3 = a2 + kstep; const char* b3 = b2 + kstep;
            if (last && has_next) S.a_ready(nxt);
            if constexpr (SP2) {
            PG8_LDB(B0, 0, 0); PG8_LDB(B1, 0, 1); PG8_SCHED; PG8_LDA(At, 0, 0); PG8_STAGE(PG8_SA(1, 1), a1 + hstep, voffA);
            PG8_WAIT_V(8); PG8_WAIT_L(0); PG8_BAR; PG8_MMA(0, 0, At, B0); PG8_MMA(0, 1, At, B1); PG8_BAR; PG8_SCHED;
            PG8_LDA(At, 0, 1); PG8_STAGE(PG8_SB(0, 0), b2, voffB); PG8_STAGE(PG8_SB(0, 1), b2 + hstep, voffB); PG8_STAGE(PG8_SA(0, 0), a2, voffA);
            PG8_WAIT_V(8); PG8_WAIT_L(0); PG8_BAR; PG8_MMA(1, 0, At, B0); PG8_MMA(1, 1, At, B1); PG8_BAR; PG8_SCHED;
            PG8_LDB(B0, 1, 0); PG8_LDB(B1, 1, 1); PG8_SCHED; PG8_LDA(At, 1, 0); PG8_STAGE(PG8_SA(0, 1), a2 + hstep, voffA);
            PG8_WAIT_V(8); PG8_WAIT_L(0); PG8_BAR; PG8_MMA(0, 0, At, B0); PG8_MMA(0, 1, At, B1); PG8_BAR; PG8_SCHED;
            PG8_LDA(At, 1, 1); PG8_STAGE(PG8_SB(1, 0), b3, voffB); PG8_STAGE(PG8_SB(1, 1), b3 + hstep, voffB); PG8_STAGE(PG8_SA(1, 0), a3, voffA);
            PG8_WAIT_V(8); PG8_WAIT_L(0); PG8_BAR; PG8_MMA(1, 0, At, B0); PG8_MMA(1, 1, At, B1); PG8_BAR; PG8_SCHED;
            } else {
            PG8_LDB(B0, 0, 0); PG8_SCHED; PG8_LDA(At, 0, 0); PG8_STAGE(PG8_SA(1, 1), a1 + hstep, voffA);
            PG8_WAIT_L(8); PG8_BAR; PG8_WAIT_L(0); PG8_MMA(0, 0, At, B0); PG8_BAR; PG8_SCHED;
            PG8_LDB(B1, 0, 1); PG8_STAGE(PG8_SB(0, 0), b2, voffB);
            PG8_BAR; PG8_WAIT_L(0); PG8_MMA(0, 1, At, B1); PG8_BAR;
            PG8_LDA(At, 0, 1); PG8_STAGE(PG8_SA(0, 0), a2, voffA);
            PG8_BAR; PG8_WAIT_L(0); PG8_MMA(1, 0, At, B0); PG8_BAR; PG8_SCHED;
            PG8_STAGE(PG8_SB(0, 1), b2 + hstep, voffB);
            PG8_WAIT_V(6); PG8_BAR; PG8_MMA(1, 1, At, B1); PG8_BAR;
            PG8_LDB(B0, 1, 0); PG8_SCHED; PG8_LDA(At, 1, 0); PG8_STAGE(PG8_SA(0, 1), a2 + hstep, voffA);
            PG8_WAIT_L(8); PG8_BAR; PG8_WAIT_L(0); PG8_MMA(0, 0, At, B0); PG8_BAR; PG8_SCHED;
            PG8_LDB(B1, 1, 1); PG8_STAGE(PG8_SB(1, 0), b3, voffB);
            PG8_BAR; PG8_WAIT_L(0); PG8_MMA(0, 1, At, B1); PG8_BAR;
            PG8_LDA(At, 1, 1); PG8_STAGE(PG8_SA(1, 0), a3, voffA);
            PG8_BAR; PG8_WAIT_L(0); PG8_MMA(1, 0, At, B0); PG8_BAR; PG8_SCHED;
            PG8_STAGE(PG8_SB(1, 1), b3 + hstep, voffB);
            PG8_WAIT_V(6); PG8_BAR; PG8_MMA(1, 1, At, B1); PG8_BAR;
            }
        }
        if constexpr (ALIGN_EPI) { if (wr == 0) PG8_BAR; }
        if constexpr (!Epi::AFTER_DRAIN) { E(acc, cur, wr, wc, fr, fq); S.done(cur); }
        if (!has_next) break;
#pragma unroll
        for (int a = 0; a < 2; ++a)
#pragma unroll
            for (int b = 0; b < 2; ++b)
#pragma unroll
                for (int m = 0; m < 4; ++m)
#pragma unroll
                    for (int n = 0; n < 2; ++n) acc[a][b][m][n] = (f32x4){0.f, 0.f, 0.f, 0.f};
        cur = nxt; cA = nA; cB = nB; ++ui;
        if constexpr (ALIGN_EPI) { if (wr == 1) PG8_BAR; }
    }
    PG8_WAIT_V(0);
    if constexpr (!ALIGN_EPI) { if (wr == 0) PG8_BAR; }
    PG8_BAR;
    if constexpr (Epi::AFTER_DRAIN) { E.fused(acc, cur, wr, wc, fr, fq, lds, wid, lane); S.done(cur); }
#undef PG8_SA
#undef PG8_SB
#undef PG8_STAGE
#undef PG8_LDA
#undef PG8_LDB
#undef PG8_MMA
#undef PG8_WAIT_V
#undef PG8_WAIT_L
#undef PG8_BAR
#undef PG8_SCHED
}
}

#ifndef MK_N_LAUNCHES
#define MK_N_LAUNCHES 1
#endif
constexpr int NPHASE = 12;
constexpr int N_LAUNCHES = MK_N_LAUNCHES;
constexpr int NWAVES = 8;

constexpr int D = 4096, MP = 8192, MS = 32, MT = MP + MS, SEQ = 2048, NBATCH = 4, QKVN = 5120, KVD = 512, DFF = 11008, NFI = 2 * DFF, NHG = 4 * D;
constexpr float RMS_EPS = 1e-5f;
constexpr float LOG2E = 1.4426950408889634f;
constexpr size_t OUT_Y = 0, OUT_WKP = (size_t)MT * D, OUT_WVP = OUT_WKP + 262144, OUT_STP = OUT_WVP + 262144, OUT_WKS = OUT_STP + 2097152, OUT_WVS = OUT_WKS + 2097152, OUT_STS = OUT_WVS + 2097152, OUT_END = OUT_STS + 16777216;

constexpr size_t MiB = 1u << 20;
constexpr size_t WS_CTL = 0, CTL_ZERO_BYTES = 1 * MiB;
constexpr size_t WS_LB = 1 * MiB;
constexpr size_t WS_WQKV = 2 * MiB, WS_WO = 42 * MiB, WS_WFI0 = 74 * MiB, WS_WFO0 = 246 * MiB, WS_WHI = 332 * MiB, WS_WHO = 460 * MiB, WS_WFI1 = 492 * MiB, WS_WFO1 = 664 * MiB;
constexpr size_t WS_XN = 750 * MiB, WS_X = 815 * MiB, WS_Q = 944 * MiB, WS_K = 1009 * MiB, WS_V = 1018 * MiB, WS_O = 1027 * MiB, WS_H = 1092 * MiB;
constexpr size_t WS_QT = 1265 * MiB, WS_KT = 1330 * MiB, WS_KP = 1395 * MiB, WS_VI = 1460 * MiB, WS_GS = 1525 * MiB, WS_DEC = 1590 * MiB, WS_SRAW = 1592 * MiB, WS_END = 1594 * MiB;
constexpr size_t WS_XQ = 815 * MiB, WS_RA = 847 * MiB, WS_WQ1 = 848 * MiB, WS_BSC = 935 * MiB;
constexpr size_t WS_WQ0 = 1265 * MiB, WS_BSC0 = 1395 * MiB, WS_WQO = 1396 * MiB, WS_BSCO = 1412 * MiB, WS_WQQ = 1413 * MiB, WS_BSCQ = 1433 * MiB;
static_assert(WS_RA - WS_XQ >= (size_t)MP * D && WS_BSC - WS_WQ1 >= (size_t)NFI * D && WS_Q - WS_BSC >= (size_t)NFI * 4, "ws map (int8)");
static_assert(WS_WO - WS_WQKV >= (size_t)QKVN * D * 2 && WS_WFO0 - WS_WFI0 >= (size_t)NFI * D * 2 && WS_WHI - WS_WFO0 >= (size_t)D * DFF * 2 && WS_WHO - WS_WHI >= (size_t)NHG * D * 2, "ws map (weights)");
static_assert(WS_X - WS_XN >= (size_t)MT * D * 2 && WS_Q - WS_X >= (size_t)MT * D * 4 && WS_K - WS_Q >= (size_t)MT * D * 2 && WS_V - WS_K >= (size_t)MT * KVD * 2 && WS_QT - WS_H >= (size_t)MT * DFF * 2, "ws map (activations)");
constexpr int CW_TMO = 0, CW_CODE = 1, CW_BAR = 4096, CW_SS = 16384, SS_STRIDE = 8448;
static_assert(CW_SS * 4 + 5 * SS_STRIDE * 8 <= (int)CTL_ZERO_BYTES, "CTL words inside the memset region");
constexpr int CW_SRES = 8384;
constexpr size_t WS_PART = 936 * MiB;
constexpr int CW_SIDE_A = 8192, CW_SIDE_B = 8256, CW_FLAG_WO = 8320;

constexpr int RING_OFF = 0, RING_BYTES = 131072;
constexpr int LDSCTL_OFF = RING_BYTES, MISC_OFF = LDSCTL_OFF + 320;
constexpr int LDS_BYTES = 147456;
constexpr int PTAB_OFF = LDSCTL_OFF + 1024;

#define GAS __attribute__((address_space(1)))
#define LAS __attribute__((address_space(3)))
typedef unsigned short bf16;
typedef unsigned v4u __attribute__((ext_vector_type(4)));
typedef unsigned v2u __attribute__((ext_vector_type(2)));
typedef float f32x4 __attribute__((ext_vector_type(4)));
typedef float f32x16 __attribute__((ext_vector_type(16)));
typedef short bf16x8 __attribute__((ext_vector_type(8)));
typedef short s16x4 __attribute__((ext_vector_type(4)));
typedef GAS unsigned gu32;
#define RLX_AGENT __ATOMIC_RELAXED, __HIP_MEMORY_SCOPE_AGENT
#define LDS_WAIT() asm volatile("s_waitcnt lgkmcnt(0)" ::: "memory")
#define VM_WAIT() asm volatile("s_waitcnt vmcnt(0)" ::: "memory")
#define MFMA32(a, b, c) __builtin_amdgcn_mfma_f32_32x32x16_bf16((a), (b), (c), 0, 0, 0)
#define MFMA16(a, b, c) __builtin_amdgcn_mfma_f32_16x16x32_bf16((a), (b), (c), 0, 0, 0)
typedef __bf16 bf16x2_t __attribute__((ext_vector_type(2)));
typedef float f32x2_t __attribute__((ext_vector_type(2)));
__device__ __forceinline__ unsigned pk2(float lo, float hi) { f32x2_t v = {lo, hi}; bf16x2_t b = __builtin_convertvector(v, bf16x2_t); return __builtin_bit_cast(unsigned, b); }
__device__ __forceinline__ float bf2f(bf16 b) { return __builtin_bit_cast(float, (unsigned)b << 16); }
__device__ __forceinline__ float fast_exp2(float x) { return __builtin_amdgcn_exp2f(x); }
__device__ __forceinline__ float fast_rcp(float x) { return __builtin_amdgcn_rcpf(x); }
__device__ __forceinline__ float sigmoidf_(float x) { return fast_rcp(1.0f + fast_exp2(-x * LOG2E)); }
__device__ __forceinline__ float siluf_(float x) { return x * sigmoidf_(x); }
__device__ __forceinline__ int crow(int reg, int h) { return (reg & 3) + 8 * (reg >> 2) + 4 * h; }
typedef short v4i16_t __attribute__((ext_vector_type(4)));
__device__ __forceinline__ s16x4 tr_read(const LAS unsigned char* p) { return __builtin_bit_cast(s16x4, __builtin_amdgcn_ds_read_tr16_b64_v4i16((LAS v4i16_t*)p)); }
__device__ __forceinline__ bf16x8 tr_frag(const LAS unsigned char* p_lo, const LAS unsigned char* p_hi) { const s16x4 lo = tr_read(p_lo), hi = tr_read(p_hi); return __builtin_shufflevector(lo, hi, 0, 1, 2, 3, 4, 5, 6, 7); }
typedef unsigned long long ssq_t;
__device__ __forceinline__ ssq_t ss_fix(float sq) { return (ssq_t)(sq * 16777216.0f + 0.5f); }
__device__ __forceinline__ float ss_rstd(const ssq_t* ss, int r) { return __builtin_amdgcn_rsqf((float)ss[r] * (1.0f / (16777216.0f * D)) + RMS_EPS); }
__device__ __forceinline__ float wave_sum(float v) {
#pragma unroll
    for (int o = 1; o < 64; o <<= 1) v += __shfl_xor(v, o);
    return v;
}
__device__ __forceinline__ float wave_max(float v) {
#pragma unroll
    for (int o = 1; o < 64; o <<= 1) v = fmaxf(v, __shfl_xor(v, o));
    return v;
}
#define XB_TMO      128
#define XB_XCNT(j)  (256  + 64 * (j))
#define XB_XSUB(j)  (1280 + 64 * (j))
#define XB_XGEN(j)  (2304 + 64 * (j))
#define XB_TOP      3328
#define XB_TOPGEN   3392
#define XCD_BAR_WORDS 3456
#define XB_SPIN_CAP (1u << 18)

__device__ __forceinline__ unsigned xb_ld(unsigned* p)              { return __hip_atomic_load(p, __ATOMIC_RELAXED, __HIP_MEMORY_SCOPE_AGENT); }
__device__ __forceinline__ unsigned xb_add(unsigned* p, unsigned v) { return __hip_atomic_fetch_add(p, v, __ATOMIC_RELAXED, __HIP_MEMORY_SCOPE_AGENT); }
__device__ __forceinline__ unsigned xb_xcc_id() { return (unsigned)__builtin_amdgcn_s_getreg((3 << 11) | 20) & 0xFu; }
#define XB_SPIN(cond, bar) do { unsigned _sp = 0; while (cond) { __builtin_amdgcn_s_sleep(1); \
    if ((++_sp & 255u) == 0u) { if (xb_ld(&(bar)[XB_TMO])) break; if (_sp > XB_SPIN_CAP) { atomicAdd(&(bar)[XB_TMO], 1u); break; } } } } while (0)

struct XcdBarrier {
    unsigned* bar; unsigned x;
    volatile LAS unsigned* st;
};

__device__ __forceinline__ XcdBarrier xcd_barrier_post(unsigned* bar, volatile LAS unsigned* st) {
    XcdBarrier b; b.bar = bar; b.x = xb_xcc_id(); b.st = st;
    if (threadIdx.x == 0) (void)xb_add(&bar[XB_XCNT(b.x)], 1u);
    return b;
}
__device__ __forceinline__ void xcd_barrier_complete(unsigned* bar, unsigned x, unsigned& nloc, unsigned& nx) {
    const unsigned G = gridDim.x * gridDim.y * gridDim.z;
    unsigned sum, cnt, mine, sp = 0u;
    for (;;) {
        sum = 0u; cnt = 0u; mine = 0u;
#pragma unroll
        for (unsigned j = 0; j < 16; ++j) { const unsigned c = xb_ld(&bar[XB_XCNT(j)]); sum += c; cnt += (c > 0u) ? 1u : 0u; mine = (j == x) ? c : mine; }
        if (sum == G) break;
        __builtin_amdgcn_s_sleep(1);
        if ((++sp & 255u) == 0u) { if (xb_ld(&bar[XB_TMO])) break; if (sp > XB_SPIN_CAP) { atomicAdd(&bar[XB_TMO], 1u); break; } }
    }
    nloc = mine > 0u ? mine : 1u; nx = cnt > 0u ? cnt : 1u;
}

__device__ __forceinline__ void xcd_barrier(const XcdBarrier& b) {
    asm volatile("s_waitcnt vmcnt(0)" ::: "memory");
    __syncthreads();
    if (threadIdx.x == 0) {
        unsigned* bar = b.bar;
        __builtin_amdgcn_s_waitcnt(0);
        unsigned nloc = b.st[0], nx = b.st[1];
        if (nloc == 0u) { xcd_barrier_complete(bar, b.x, nloc, nx); b.st[0] = nloc; b.st[1] = nx; }
        const unsigned old = xb_add(&bar[XB_XSUB(b.x)], 1u);
        const unsigned gen = old / nloc;
        if (old + 1u == (gen + 1u) * nloc) {
            __builtin_amdgcn_fence(__ATOMIC_RELEASE, "agent");
            asm volatile("s_waitcnt vmcnt(0)" ::: "memory");
            const unsigned og = xb_add(&bar[XB_TOP], 1u);
            const unsigned tg = og / nx;
            if (og + 1u == (tg + 1u) * nx) xb_add(&bar[XB_TOPGEN], 1u);
            else XB_SPIN(xb_ld(&bar[XB_TOPGEN]) == tg, bar);
            __builtin_amdgcn_fence(__ATOMIC_ACQUIRE, "agent");
            xb_add(&bar[XB_XGEN(b.x)], 1u);
            asm volatile("s_waitcnt vmcnt(0)" ::: "memory");
        } else {
            XB_SPIN(xb_ld(&bar[XB_XGEN(b.x)]) == gen, bar);
            __builtin_amdgcn_fence(__ATOMIC_ACQUIRE, "agent");
            asm volatile("s_waitcnt vmcnt(0)" ::: "memory");
        }
    }
    __syncthreads();
}

__device__ __forceinline__ void side_barrier(unsigned* ctr, unsigned target, unsigned* tmo) {
    asm volatile("s_waitcnt vmcnt(0)" ::: "memory");
    __syncthreads();
    if (threadIdx.x == 0) {
        __builtin_amdgcn_fence(__ATOMIC_RELEASE, "agent");
        asm volatile("s_waitcnt vmcnt(0)" ::: "memory");
        (void)xb_add(ctr, 1u);
        XB_SPIN(xb_ld(ctr) < target, tmo - XB_TMO);
        __builtin_amdgcn_fence(__ATOMIC_ACQUIRE, "agent");
        asm volatile("s_waitcnt vmcnt(0)" ::: "memory");
    }
    __syncthreads();
}

typedef pg8::Unit Unit;
template <bool Q8> struct EpiQKVT {
    static constexpr bool PERM = true, AFTER_DRAIN = false;
    bf16 *Q, *K, *V; const float* bias; float *wk, *wv; const ssq_t* ss; const float* ra; const float* bs; int pn0;
    __device__ __forceinline__ void operator()(const f32x4 (&acc)[2][2][4][2], const Unit& u, int wr, int wc, int fr, int fq) const {
        const int pn = u.pn + pn0; const int row0 = u.pm * 256 + wr * 64 + fr, colt = pn * 256;
        bf16* base; int ldc, cc; float* win = nullptr;
        if (pn < 16) { base = Q; ldc = D; cc = colt; } else if (pn < 18) { base = K; ldc = KVD; cc = colt - D; win = wk; } else { base = V; ldc = KVD; cc = colt - D - KVD; win = wv; }
        const int col0 = cc + wc * 32 + 8 * fq, bcol0 = colt + wc * 32 + 8 * fq;
        f32x4 bv[2][2];
#pragma unroll
        for (int bj = 0; bj < 2; ++bj)
#pragma unroll
            for (int n = 0; n < 2; ++n) bv[bj][n] = *(const f32x4*)(bias + bcol0 + bj * 128 + 4 * n);
        const bool dowin = (win != nullptr) && ((u.pm & 7) == 7);
        float rsv[2][4];
#pragma unroll
        for (int ai = 0; ai < 2; ++ai)
#pragma unroll
            for (int m = 0; m < 4; ++m) rsv[ai][m] = Q8 ? ra[row0 + ai * 128 + m * 16] : ss_rstd(ss, row0 + ai * 128 + m * 16);
        f32x4 bsv[2][2];
        if constexpr (Q8) {
#pragma unroll
            for (int bj = 0; bj < 2; ++bj)
#pragma unroll
                for (int n = 0; n < 2; ++n) bsv[bj][n] = *(const f32x4*)(bs + bcol0 + bj * 128 + 4 * n);
        }
#pragma unroll
        for (int ai = 0; ai < 2; ++ai)
#pragma unroll
            for (int m = 0; m < 4; ++m) { const int r = row0 + ai * 128 + m * 16; bf16* rowp = base + (size_t)r * ldc + col0; const float rs = rsv[ai][m];
#pragma unroll
                for (int bj = 0; bj < 2; ++bj) { f32x4 v0, v1;
                    if constexpr (Q8) { const pg8::i32x4 i0 = __builtin_bit_cast(pg8::i32x4, acc[ai][bj][m][0]), i1 = __builtin_bit_cast(pg8::i32x4, acc[ai][bj][m][1]);
#pragma unroll
                        for (int j = 0; j < 4; ++j) { v0[j] = (float)i0[j] * (rs * bsv[bj][0][j]) + bv[bj][0][j]; v1[j] = (float)i1[j] * (rs * bsv[bj][1][j]) + bv[bj][1][j]; } }
                    else { v0 = acc[ai][bj][m][0] * rs + bv[bj][0]; v1 = acc[ai][bj][m][1] * rs + bv[bj][1]; }
                    v4u w; w.x = pk2(v0[0], v0[1]); w.y = pk2(v0[2], v0[3]); w.z = pk2(v1[0], v1[1]); w.w = pk2(v1[2], v1[3]);
                    *(v4u*)(rowp + bj * 128) = w;
                    if (ai == 1 && dowin) { float* wp = win + ((size_t)((u.pm >> 3) * 128 + wr * 64 + m * 16 + fr) * KVD + col0 + bj * 128); *(f32x4*)wp = v0; *(f32x4*)(wp + 4) = v1; } } }
    }
};
typedef EpiQKVT<false> EpiQKV;
template <bool Q8> struct EpiResT {
    static constexpr bool PERM = true, AFTER_DRAIN = false;
    bf16* xb; float* out; const float* bias; ssq_t* ss; const float* ra; const float* bs;
    __device__ __forceinline__ void operator()(const f32x4 (&acc)[2][2][4][2], const Unit& u, int wr, int wc, int fr, int fq) const {
        const int row0 = u.pm * 256 + wr * 64 + fr, col0 = u.pn * 256 + wc * 32 + 8 * fq;
        f32x4 bv[2][2], bsv[2][2]; float rsv[2][4];
        if constexpr (Q8) {
#pragma unroll
            for (int bj = 0; bj < 2; ++bj)
#pragma unroll
                for (int n = 0; n < 2; ++n) bsv[bj][n] = *(const f32x4*)(bs + col0 + bj * 128 + 4 * n);
#pragma unroll
            for (int ai = 0; ai < 2; ++ai)
#pragma unroll
                for (int m = 0; m < 4; ++m) rsv[ai][m] = ra[row0 + ai * 128 + m * 16];
        }
#pragma unroll
        for (int bj = 0; bj < 2; ++bj)
#pragma unroll
            for (int n = 0; n < 2; ++n) bv[bj][n] = bias ? *(const f32x4*)(bias + col0 + bj * 128 + 4 * n) : (f32x4){0.f, 0.f, 0.f, 0.f};
#pragma unroll
        for (int ai = 0; ai < 2; ++ai) {
          v4u xra[2][4][2];
          if (!Q8 || true) {
#pragma unroll
            for (int m = 0; m < 4; ++m)
#pragma unroll
                for (int bj = 0; bj < 2; ++bj) xra[ai][m][bj] = *(const v4u*)(xb + (unsigned)(row0 + ai * 128 + m * 16) * D + col0 + bj * 128);
          }
#pragma unroll
            for (int m = 0; m < 4; ++m) { const int r = row0 + ai * 128 + m * 16; const unsigned off = (unsigned)r * D + col0; float sq = 0.f;
#pragma unroll
                for (int bj = 0; bj < 2; ++bj) { const v4u xr1 = xra[ai][m][bj]; const unsigned xw_[4] = {xr1.x, xr1.y, xr1.z, xr1.w}; float o[8];
                    f32x4 av[2] = {acc[ai][bj][m][0], acc[ai][bj][m][1]};
                    if constexpr (Q8) {
#pragma unroll
                        for (int n = 0; n < 2; ++n) { const pg8::i32x4 iv = __builtin_bit_cast(pg8::i32x4, acc[ai][bj][m][n]);
#pragma unroll
                            for (int j = 0; j < 4; ++j) av[n][j] = (float)iv[j] * (rsv[ai][m] * bsv[bj][n][j]); } }
#pragma unroll
                    for (int e = 0; e < 8; ++e) { const float xv = __builtin_bit_cast(float, (e & 1) ? (xw_[e >> 1] & 0xffff0000u) : (xw_[e >> 1] << 16)); o[e] = xv + av[e >> 2][e & 3] + bv[bj][e >> 2][e & 3]; }
                    if (out) { *(f32x4*)(out + off + bj * 128) = (f32x4){o[0], o[1], o[2], o[3]}; *(f32x4*)(out + off + bj * 128 + 4) = (f32x4){o[4], o[5], o[6], o[7]};
#pragma unroll
                        for (int e = 0; e < 8; ++e) sq += o[e] * o[e]; }
                    else { v4u w; w.x = pk2(o[0], o[1]); w.y = pk2(o[2], o[3]); w.z = pk2(o[4], o[5]); w.w = pk2(o[6], o[7]); *(v4u*)(xb + off + bj * 128) = w;
                        const unsigned ww_[4] = {w.x, w.y, w.z, w.w};
#pragma unroll
                        for (int e = 0; e < 8; ++e) { const float xv = __builtin_bit_cast(float, (e & 1) ? (ww_[e >> 1] & 0xffff0000u) : (ww_[e >> 1] << 16)); sq += xv * xv; } } }
                sq += __shfl_xor(sq, 16); sq += __shfl_xor(sq, 32);
                if (fq == 0) __hip_atomic_fetch_add(ss + r, ss_fix(sq), RLX_AGENT);
                asm volatile("" ::: "memory"); }
        }
    }
};
typedef EpiResT<false> EpiRes;
struct EpiSwiGLU {
    static constexpr bool PERM = true, AFTER_DRAIN = false;
    bf16* H; const ssq_t* ss;
    __device__ __forceinline__ void operator()(const f32x4 (&acc)[2][2][4][2], const Unit& u, int wr, int wc, int fr, int fq) const {
        const int row0 = u.pm * 256 + wr * 64 + fr, col0 = u.pn * 128 + wc * 32 + 8 * fq;
        float rsv[2][4];
#pragma unroll
        for (int ai = 0; ai < 2; ++ai)
#pragma unroll
            for (int m = 0; m < 4; ++m) rsv[ai][m] = ss_rstd(ss, row0 + ai * 128 + m * 16);
#pragma unroll
        for (int ai = 0; ai < 2; ++ai)
#pragma unroll
            for (int m = 0; m < 4; ++m) { const int r = row0 + ai * 128 + m * 16; const float rs = rsv[ai][m];
                float hv[8];
#pragma unroll
                for (int n = 0; n < 2; ++n)
#pragma unroll
                    for (int j = 0; j < 4; ++j) { const float g = acc[ai][0][m][n][j] * rs, up = acc[ai][1][m][n][j] * rs; hv[4 * n + j] = siluf_(g) * up; }
                v4u w; w.x = pk2(hv[0], hv[1]); w.y = pk2(hv[2], hv[3]); w.z = pk2(hv[4], hv[5]); w.w = pk2(hv[6], hv[7]);
                *(v4u*)(H + (size_t)r * DFF + col0) = w; }
    }
};
struct EpiSwiGLUQ {
    static constexpr bool PERM = true, AFTER_DRAIN = false;
    bf16* H; const float* ra; const float* bs;
    __device__ __forceinline__ void operator()(const f32x4 (&acc)[2][2][4][2], const Unit& u, int wr, int wc, int fr, int fq) const {
        const int row0 = u.pm * 256 + wr * 64 + fr, col0 = u.pn * 128 + wc * 32 + 8 * fq, bcol0 = u.pn * 256 + wc * 32 + 8 * fq;
        f32x4 bv[2][2]; float rsv[2][4];
#pragma unroll
        for (int bj = 0; bj < 2; ++bj)
#pragma unroll
            for (int n = 0; n < 2; ++n) bv[bj][n] = *(const f32x4*)(bs + bcol0 + bj * 128 + 4 * n);
#pragma unroll
        for (int ai = 0; ai < 2; ++ai)
#pragma unroll
            for (int m = 0; m < 4; ++m) rsv[ai][m] = ra[row0 + ai * 128 + m * 16];
#pragma unroll
        for (int ai = 0; ai < 2; ++ai)
#pragma unroll
            for (int m = 0; m < 4; ++m) { const int r = row0 + ai * 128 + m * 16; const float rs = rsv[ai][m];
                float hv[8];
#pragma unroll
                for (int n = 0; n < 2; ++n)
                {   const pg8::i32x4 gi = __builtin_bit_cast(pg8::i32x4, acc[ai][0][m][n]), ui = __builtin_bit_cast(pg8::i32x4, acc[ai][1][m][n]);
#pragma unroll
                    for (int j = 0; j < 4; ++j) { const float g = (float)gi[j] * (rs * bv[0][n][j]), up = (float)ui[j] * (rs * bv[1][n][j]);
                        hv[4 * n + j] = siluf_(g) * up; } }
                v4u w; w.x = pk2(hv[0], hv[1]); w.y = pk2(hv[2], hv[3]); w.z = pk2(hv[4], hv[5]); w.w = pk2(hv[6], hv[7]);
                *(v4u*)(H + (size_t)r * DFF + col0) = w; }
    }
};
struct EpiHgrnIn {
    static constexpr bool PERM = true, AFTER_DRAIN = false;
    bf16 *QT, *KT, *VI, *GS; float* DEC; const float* lb; const ssq_t* ss;
    __device__ __forceinline__ void operator()(f32x4 (&acc)[2][2][4][2], const Unit& u, int wr, int wc, int fr, int fq) const {
        const int row0 = u.pm * 256 + wr * 64 + fr;
        const int head = 4 * (u.pn >> 3) + (u.pn & 3);
        float rsv[2][4];
#pragma unroll
        for (int ai = 0; ai < 2; ++ai)
#pragma unroll
            for (int m = 0; m < 4; ++m) rsv[ai][m] = ss_rstd(ss, row0 + ai * 128 + m * 16);
        if (u.pn & 4) {
            const int col0 = head * 128 + wc * 32 + 8 * fq;
#pragma unroll
            for (int ai = 0; ai < 2; ++ai)
#pragma unroll
                for (int m = 0; m < 4; ++m) { const int r = row0 + ai * 128 + m * 16; const float rs = rsv[ai][m];
                    float a[8], g[8];
#pragma unroll
                    for (int n = 0; n < 2; ++n)
#pragma unroll
                        for (int j = 0; j < 4; ++j) { a[4 * n + j] = acc[ai][0][m][n][j] * rs; g[4 * n + j] = siluf_(acc[ai][1][m][n][j] * rs); }
                    v4u w; w.x = pk2(a[0], a[1]); w.y = pk2(a[2], a[3]); w.z = pk2(a[4], a[5]); w.w = pk2(a[6], a[7]); *(v4u*)(VI + (size_t)r * D + col0) = w;
                    w.x = pk2(g[0], g[1]); w.y = pk2(g[2], g[3]); w.z = pk2(g[4], g[5]); w.w = pk2(g[6], g[7]); *(v4u*)(GS + (size_t)r * D + col0) = w; }
            return;
        }
        const int col0 = head * 128 + wc * 32 + 8 * fq;
#pragma unroll
        for (int ai = 0; ai < 2; ++ai) {
            v2u hq[4], hk[4];
#pragma unroll
            for (int n = 0; n < 2; ++n) {
                float pf[4][4], lbv[4];
#pragma unroll
                for (int j = 0; j < 4; ++j) lbv[j] = 1.0f - lb[col0 + 4 * n + j];
#pragma unroll
                for (int m = 0; m < 4; ++m) { const float rs = rsv[ai][m];
#pragma unroll
                    for (int j = 0; j < 4; ++j) { const float ex = fast_exp2(acc[ai][1][m][n][j] * rs * LOG2E);
                        const float k1 = lbv[j] * fast_rcp(1.0f + ex);
                        acc[ai][1][m][n][j] = k1; pf[m][j] = 1.0f - k1;
                        acc[ai][0][m][n][j] = siluf_(acc[ai][0][m][n][j] * rs) * 0.08838834764831845f; }
                    __builtin_amdgcn_sched_barrier(0); }
                float run[4] = {1.f, 1.f, 1.f, 1.f};
#pragma unroll
                for (int m = 0; m < 4; ++m)
#pragma unroll
                    for (int j = 0; j < 4; ++j) { float v = pf[m][j];
                        v *= __builtin_bit_cast(float, __builtin_amdgcn_update_dpp(0x3f800000, __builtin_bit_cast(int, v), 0x111, 0xf, 0xf, false));
                        v *= __builtin_bit_cast(float, __builtin_amdgcn_update_dpp(0x3f800000, __builtin_bit_cast(int, v), 0x112, 0xf, 0xf, false));
                        v *= __builtin_bit_cast(float, __builtin_amdgcn_update_dpp(0x3f800000, __builtin_bit_cast(int, v), 0x114, 0xf, 0xf, false));
                        v *= __builtin_bit_cast(float, __builtin_amdgcn_update_dpp(0x3f800000, __builtin_bit_cast(int, v), 0x118, 0xf, 0xf, false));
                        const float tot = __shfl(v, 15, 16); pf[m][j] = v * run[j]; run[j] *= tot; }
#pragma unroll
                for (int m = 0; m < 4; ++m) { const int r = row0 + ai * 128 + m * 16; float qt[4], kt[4];
#pragma unroll
                    for (int j = 0; j < 4; ++j) { const float p = pf[m][j]; const float k1 = acc[ai][1][m][n][j];
                        qt[j] = acc[ai][0][m][n][j] * p; kt[j] = k1 * fast_rcp(p); }
                    v2u wq, wk; const unsigned off = (unsigned)r * D + col0;
                    wq.x = pk2(qt[0], qt[1]); wq.y = pk2(qt[2], qt[3]); wk.x = pk2(kt[0], kt[1]); wk.y = pk2(kt[2], kt[3]);
                    if (n == 0) { hq[m] = wq; hk[m] = wk; }
                    else { *(v4u*)(QT + off) = (v4u){hq[m].x, hq[m].y, wq.x, wq.y}; *(v4u*)(KT + off) = (v4u){hk[m].x, hk[m].y, wk.x, wk.y}; }
                    __builtin_amdgcn_sched_barrier(0); }
                if (fr == 0) { const int chunk = u.pm * 4 + ai * 2 + wr; *(f32x4*)(DEC + (unsigned)chunk * D + col0 + 4 * n) = (f32x4){run[0], run[1], run[2], run[3]}; }
                asm volatile("" ::: "memory");
            } }
    }
};

__device__ __forceinline__ int dst_row(int map, int n) {
    if (map == 0) return n;
    if (map == 1) { const int up = n >= DFF ? 1 : 0, j = n - up * DFF; return 256 * (j >> 7) + 128 * up + (j & 127); }
    const int part = n >> 12, j = n & 4095, head = j >> 7, d = j & 127; return 256 * (8 * (head >> 2) + 4 * (part >> 1) + (head & 3)) + 128 * (part & 1) + d;
}
struct CvItem { const float* W; bf16* WT; const float* kw; int K, N, map, item; };
__device__ __forceinline__ void cv_load(const CvItem& c, int lane, float (&v)[32], float& kwa) {
    const int nblk = c.N / 32, kb = c.item / nblk, nb = c.item % nblk, k0 = 64 * kb, n0 = 32 * nb;
    kwa = c.kw ? c.kw[k0 + lane] : 1.0f;
    const float* src = c.W + (size_t)(k0 + (lane >> 5)) * c.N + n0 + (lane & 31);
#pragma unroll
    for (int i = 0; i < 32; ++i) v[i] = __builtin_nontemporal_load(src + (size_t)(2 * i) * c.N);
}
__device__ __forceinline__ void cv_store(const CvItem& c, int lane, const float (&v)[32], float kwa, LAS float* scr) {
    const int nblk = c.N / 32, kb = c.item / nblk, nb = c.item % nblk, k0 = 64 * kb, n0 = 32 * nb;
#pragma unroll
    for (int i = 0; i < 32; ++i) { const int kk = 2 * i + (lane >> 5); scr[kk * 33 + (lane & 31)] = v[i] * __shfl(kwa, kk); }
    LDS_WAIT(); asm volatile("" ::: "memory");
    const int cc = lane & 7; const int r0 = dst_row(c.map, n0);
#pragma unroll
    for (int j = 0; j < 4; ++j) { const int n = (lane >> 3) + 8 * j; const LAS float* s = scr + (8 * cc) * 33 + n;
        v4u o; o.x = pk2(s[0 * 33], s[1 * 33]); o.y = pk2(s[2 * 33], s[3 * 33]); o.z = pk2(s[4 * 33], s[5 * 33]); o.w = pk2(s[6 * 33], s[7 * 33]);
        __builtin_nontemporal_store(o, (GAS v4u*)(c.WT + (size_t)(r0 + n) * c.K + k0 + 8 * cc)); }
    LDS_WAIT(); asm volatile("" ::: "memory");
}
__device__ __forceinline__ void row_to_bf16_ss(const float* xrow, bf16* orow, ssq_t* ssrow, int lane, signed char* qrow = nullptr, float* qscale = nullptr) {
    const GAS f32x4* xr = (const GAS f32x4*)xrow + lane;
    f32x4 v[16]; float s = 0.f;
#pragma unroll
    for (int j = 0; j < 16; ++j) { v[j] = xr[64 * j]; s += (v[j].x * v[j].x + v[j].y * v[j].y) + (v[j].z * v[j].z + v[j].w * v[j].w); }
    s = wave_sum(s);
    if (qrow) {
        float amax = 0.f;
#pragma unroll
        for (int j = 0; j < 16; ++j) amax = fmaxf(fmaxf(amax, fmaxf(fabsf(v[j].x), fabsf(v[j].y))), fmaxf(fabsf(v[j].z), fabsf(v[j].w)));
        amax = wave_max(amax); const float inv = amax > 0.f ? 127.0f / amax : 0.f;
        GAS unsigned* q4 = (GAS unsigned*)qrow + lane;
#pragma unroll
        for (int j = 0; j < 16; ++j) { const int a = (int)__builtin_rintf(v[j].x * inv), b = (int)__builtin_rintf(v[j].y * inv), c = (int)__builtin_rintf(v[j].z * inv), d = (int)__builtin_rintf(v[j].w * inv);
            q4[64 * j] = (unsigned)(a & 255) | ((unsigned)(b & 255) << 8) | ((unsigned)(c & 255) << 16) | ((unsigned)(d & 255) << 24); }
        if (lane == 0) *qscale = amax * (1.0f / 127.0f) * __builtin_amdgcn_rsqf(s * (1.0f / D) + RMS_EPS);
    }
    GAS v2u* o8 = (GAS v2u*)orow + lane;
#pragma unroll
    for (int j = 0; j < 16; ++j) { v2u p; p.x = pk2(v[j].x, v[j].y); p.y = pk2(v[j].z, v[j].w); o8[64 * j] = p; }
    if (lane == 0) *ssrow = ss_fix(s);
}

template <int NBK> __device__ __forceinline__ void sgemm_unit(const bf16* A, int K, const bf16* B0, const bf16* B1, LAS float* red, int wave, int lane, int tid, float (&out)[NBK]) {
    const int fr = lane & 15, fq = lane >> 4;
    f32x4 acc[NBK][2];
#pragma unroll
    for (int nb = 0; nb < NBK; ++nb) { acc[nb][0] = (f32x4){0.f, 0.f, 0.f, 0.f}; acc[nb][1] = (f32x4){0.f, 0.f, 0.f, 0.f}; }
    const bf16* a0p = A + (size_t)fr * K + fq * 32; const bf16* a1p = a0p + (size_t)16 * K;
    const bf16* b0p = B0 + (size_t)fr * K + fq * 32; const bf16* b1p = B1 + (size_t)fr * K + fq * 32;
    const int ns = K >> 7;
    for (int s = wave; s < ns; s += 24) {
        bf16x8 a0[3][4], a1[3][4], b0[3][4], b1[3][4];
#pragma unroll
        for (int g = 0; g < 3; ++g) { const int sg = s + 8 * g < ns ? s + 8 * g : s; const int off = sg * 128;
#pragma unroll
            for (int j = 0; j < 4; ++j) { a0[g][j] = *(const bf16x8*)(a0p + off + 8 * j); a1[g][j] = *(const bf16x8*)(a1p + off + 8 * j); b0[g][j] = *(const bf16x8*)(b0p + off + 8 * j); if (NBK > 1) b1[g][j] = *(const bf16x8*)(b1p + off + 8 * j); } }
#pragma unroll
        for (int g = 0; g < 3; ++g) { if (s + 8 * g < ns) {
#pragma unroll
            for (int j = 0; j < 4; ++j) { acc[0][0] = MFMA16(b0[g][j], a0[g][j], acc[0][0]); acc[0][1] = MFMA16(b0[g][j], a1[g][j], acc[0][1]);
                if (NBK > 1) { acc[NBK - 1][0] = MFMA16(b1[g][j], a0[g][j], acc[NBK - 1][0]); acc[NBK - 1][1] = MFMA16(b1[g][j], a1[g][j], acc[NBK - 1][1]); } } } }
    }
#pragma unroll
    for (int nb = 0; nb < NBK; ++nb)
#pragma unroll
        for (int rb = 0; rb < 2; ++rb) *(LAS f32x4*)(red + (((wave * NBK + nb) * 2 + rb) * 64 + lane) * 4) = acc[nb][rb];
    __syncthreads();
    const int row = tid >> 4, n = tid & 15, rb = row >> 4, lp = (n >> 2) * 16 + (row & 15), rg = n & 3;
#pragma unroll
    for (int nb = 0; nb < NBK; ++nb) { float s = 0.f;
#pragma unroll
        for (int w = 0; w < 8; ++w) s += red[(((w * NBK + nb) * 2 + rb) * 64 + lp) * 4 + rg];
        out[nb] = s; }
    __syncthreads();
}

struct SampleA { bf16x8 a0[4][4], a1[4][4]; };
__device__ __forceinline__ void sample_load_a(SampleA& sa, const bf16* A, int wave, int lane) {
    const int fr = lane & 15, fq = lane >> 4; const bf16* p = A + (size_t)fr * D + fq * 32 + wave * 128;
#pragma unroll
    for (int s = 0; s < 4; ++s)
#pragma unroll
        for (int j = 0; j < 4; ++j) { sa.a0[s][j] = *(const bf16x8*)(p + s * 1024 + 8 * j); sa.a1[s][j] = *(const bf16x8*)(p + (size_t)16 * D + s * 1024 + 8 * j); }
}
template <int NBK> __device__ __forceinline__ void sgemm_unit_ra(const SampleA& sa, const bf16* B0, const bf16* B1, LAS float* red, int wave, int lane, int tid, float (&out)[NBK]) {
    const int fr = lane & 15, fq = lane >> 4;
#pragma unroll
    for (int nb = 0; nb < NBK; ++nb) { const bf16* bp = (nb == 0 ? B0 : B1) + (size_t)fr * D + fq * 32 + wave * 128;
        bf16x8 b[4][4];
#pragma unroll
        for (int s = 0; s < 4; ++s)
#pragma unroll
            for (int j = 0; j < 4; ++j) b[s][j] = *(const bf16x8*)(bp + s * 1024 + 8 * j);
        f32x4 c0 = (f32x4){0.f, 0.f, 0.f, 0.f}, c1 = (f32x4){0.f, 0.f, 0.f, 0.f};
#pragma unroll
        for (int s = 0; s < 4; ++s)
#pragma unroll
            for (int j = 0; j < 4; ++j) { c0 = MFMA16(b[s][j], sa.a0[s][j], c0); c1 = MFMA16(b[s][j], sa.a1[s][j], c1); }
        *(LAS f32x4*)(red + (((wave * NBK + nb) * 2 + 0) * 64 + lane) * 4) = c0; *(LAS f32x4*)(red + (((wave * NBK + nb) * 2 + 1) * 64 + lane) * 4) = c1; }
    __syncthreads();
    const int row = tid >> 4, n = tid & 15, rb = row >> 4, lp = (n >> 2) * 16 + (row & 15), rg = n & 3;
#pragma unroll
    for (int nb = 0; nb < NBK; ++nb) { float s = 0.f;
#pragma unroll
        for (int w = 0; w < 8; ++w) s += red[(((w * NBK + nb) * 2 + rb) * 64 + lp) * 4 + rg];
        out[nb] = s; }
    __syncthreads();
}

typedef int v4i_t __attribute__((ext_vector_type(4)));
struct SampleA8 { v4i_t a0[2][4], a1[2][4]; };
__device__ __forceinline__ void sample_load_a8(SampleA8& sa, const signed char* A, int wave, int lane) {
    const int fr = lane & 15, fq = lane >> 4; const signed char* p = A + (size_t)fr * D + fq * 64 + wave * 256;
#pragma unroll
    for (int s = 0; s < 2; ++s)
#pragma unroll
        for (int j = 0; j < 4; ++j) { sa.a0[s][j] = *(const v4i_t*)(p + s * 2048 + 16 * j); sa.a1[s][j] = *(const v4i_t*)(p + (size_t)16 * D + s * 2048 + 16 * j); }
}
__device__ __forceinline__ void sgemm_unit_i8x2(const SampleA8& sa, const signed char* B0, const signed char* B1, LAS float* red, int wave, int lane, int tid, float (&out)[2]) {
    const int fr = lane & 15, fq = lane >> 4;
    v4i_t b[2][2][4];
#pragma unroll
    for (int nb = 0; nb < 2; ++nb) { const signed char* bp = (nb == 0 ? B0 : B1) + (size_t)fr * D + fq * 64 + wave * 256;
#pragma unroll
        for (int s = 0; s < 2; ++s)
#pragma unroll
            for (int j = 0; j < 4; ++j) b[nb][s][j] = *(const v4i_t*)(bp + s * 2048 + 16 * j); }
#pragma unroll
    for (int nb = 0; nb < 2; ++nb) { v4i_t c0 = (v4i_t){0, 0, 0, 0}, c1 = (v4i_t){0, 0, 0, 0};
#pragma unroll
        for (int s = 0; s < 2; ++s)
#pragma unroll
            for (int j = 0; j < 4; ++j) { c0 = __builtin_amdgcn_mfma_i32_16x16x64_i8(b[nb][s][j], sa.a0[s][j], c0, 0, 0, 0); c1 = __builtin_amdgcn_mfma_i32_16x16x64_i8(b[nb][s][j], sa.a1[s][j], c1, 0, 0, 0); }
        *(LAS v4i_t*)(red + (((wave * 2 + nb) * 2 + 0) * 64 + lane) * 4) = c0; *(LAS v4i_t*)(red + (((wave * 2 + nb) * 2 + 1) * 64 + lane) * 4) = c1; }
    __syncthreads();
    const int row = tid >> 4, n = tid & 15, rb = row >> 4, lp = (n >> 2) * 16 + (row & 15), rg = n & 3;
#pragma unroll
    for (int nb = 0; nb < 2; ++nb) { int s = 0;
#pragma unroll
        for (int w = 0; w < 8; ++w) s += ((const LAS int*)red)[(((w * 2 + nb) * 2 + rb) * 64 + lp) * 4 + rg];
        out[nb] = (float)s; }
    __syncthreads();
}

#define LDS_BARRIER() do { asm volatile("s_waitcnt lgkmcnt(0)" ::: "memory"); __builtin_amdgcn_s_barrier(); asm volatile("" ::: "memory"); } while (0)
constexpr int AT_KS = 144, AT_VS = 192, AT_KOFF = 0, AT_VOFF = 256 * AT_KS;
static_assert(AT_VOFF + 256 * AT_VS <= RING_BYTES, "attention LDS");
struct AttnKV { v4u k[4], v[4]; };
__device__ __forceinline__ void attn_kv_load(AttnKV& t, const bf16* Kb, const bf16* Vb, int b, int hkv, int n, int tid) {
    const int r0 = b * SEQ + n * 128;
#pragma unroll
    for (int i = 0; i < 4; ++i) { const int p = tid + 512 * i, key = p >> 3, ch = p & 7; const int gr = r0 - 128 + key; t.k[i] = (v4u){0u, 0u, 0u, 0u}; t.v[i] = (v4u){0u, 0u, 0u, 0u};
        if (n > 0 || key >= 128) { t.k[i] = *(const v4u*)(Kb + (size_t)gr * KVD + hkv * 64 + ch * 8); t.v[i] = *(const v4u*)(Vb + (size_t)gr * KVD + hkv * 64 + ch * 8); } }
}
__device__ __forceinline__ void attn_kv_store(const AttnKV& t, LAS unsigned char* lds, int tid) {
#pragma unroll
    for (int i = 0; i < 4; ++i) { const int p = tid + 512 * i, key = p >> 3, ch = p & 7; *(LAS v4u*)(lds + AT_KOFF + key * AT_KS + ch * 16) = t.k[i]; *(LAS v4u*)(lds + AT_VOFF + key * AT_VS + ch * 16) = t.v[i]; }
}
__device__ __forceinline__ void attn_prompt_unit(LAS unsigned char* lds, const bf16* Q, const bf16* Kb, const bf16* Vb, bf16* O, const float* sinks, int b, int hkv, int n, AttnKV& kv, bool has_next, int nb, int nhkv, int nn, int tid, int wave, int lane) {
    const int r0 = b * SEQ + n * 128;
    LDS_BARRIER();
    attn_kv_store(kv, lds, tid);
    LDS_BARRIER();
    const int hq = hkv * 8 + wave, h = lane >> 5, l31 = lane & 31, i16 = lane & 15, q4 = i16 >> 2, p4 = i16 & 3, blk = (lane >> 4) & 1;
    const float sink2 = sinks[hq] * LOG2E; const float sc2 = 0.125f * LOG2E; const float ninf = -__builtin_inff();
    bf16x8 qf[4], qn[4];
    { const bf16* qp = Q + (size_t)(r0 + l31) * D + hq * 64 + 8 * h;
#pragma unroll
      for (int ks = 0; ks < 4; ++ks) qf[ks] = *(const bf16x8*)(qp + ks * 16); }
    for (int qs = 0; qs < 4; ++qs) {
        if (qs < 3) { const bf16* qp = Q + (size_t)(r0 + (qs + 1) * 32 + l31) * D + hq * 64 + 8 * h;
#pragma unroll
            for (int ks = 0; ks < 4; ++ks) qn[ks] = *(const bf16x8*)(qp + ks * 16); }
        else if (has_next) attn_kv_load(kv, Kb, Vb, nb, nhkv, nn, tid);
        f32x16 st[5];
        const int qi = qs * 32 + l31; float mx = sink2;
        const LAS unsigned char* kbase = lds + AT_KOFF + (qs * 32 + l31) * AT_KS + 16 * h;
#pragma unroll
        for (int i = 0; i < 5; ++i) { f32x16 a;
#pragma unroll
            for (int r = 0; r < 16; ++r) a[r] = 0.f;
#pragma unroll
            for (int ks = 0; ks < 4; ++ks) { const bf16x8 kf = *(const LAS bf16x8*)(kbase + i * 32 * AT_KS + ks * 32); a = MFMA32(kf, qf[ks], a); }
            const bool prevblk = (qs + i) < 4;
            if (prevblk && n == 0) {
#pragma unroll
                for (int r = 0; r < 16; ++r) a[r] = ninf;
            } else if (i == 0) {
#pragma unroll
                for (int r = 0; r < 16; ++r) { const float s = (crow(r, h) > l31) ? a[r] * sc2 : ninf; a[r] = s; mx = fmaxf(mx, s); }
            } else if (i == 4) {
#pragma unroll
                for (int r = 0; r < 16; ++r) { const float s = (crow(r, h) <= l31) ? a[r] * sc2 : ninf; a[r] = s; mx = fmaxf(mx, s); }
            } else {
#pragma unroll
                for (int r = 0; r < 16; ++r) { const float s = a[r] * sc2; a[r] = s; mx = fmaxf(mx, s); }
            }
            st[i] = a; }
        mx = fmaxf(mx, __shfl_xor(mx, 32));
        float sum = 0.f;
#pragma unroll
        for (int i = 0; i < 5; ++i)
#pragma unroll
            for (int r = 0; r < 16; ++r) { const float p = fast_exp2(st[i][r] - mx); st[i][r] = p; sum += p; }
        sum += __shfl_xor(sum, 32);
        const float inv = fast_rcp(sum + fast_exp2(sink2 - mx));
        f32x16 oa[2];
#pragma unroll
        for (int r = 0; r < 16; ++r) { oa[0][r] = 0.f; oa[1][r] = 0.f; }
        const LAS unsigned char* vbase = lds + AT_VOFF + (qs * 32 + 4 * h + q4) * AT_VS + 32 * blk + 8 * p4;
#pragma unroll
        for (int i = 0; i < 5; ++i)
#pragma unroll
            for (int s = 0; s < 2; ++s) { v4u pw; pw.x = pk2(st[i][8 * s + 0], st[i][8 * s + 1]); pw.y = pk2(st[i][8 * s + 2], st[i][8 * s + 3]); pw.z = pk2(st[i][8 * s + 4], st[i][8 * s + 5]); pw.w = pk2(st[i][8 * s + 6], st[i][8 * s + 7]);
                const bf16x8 pf = __builtin_bit_cast(bf16x8, pw);
#pragma unroll
                for (int db = 0; db < 2; ++db) { const LAS unsigned char* vp = vbase + (i * 32 + 16 * s) * AT_VS + db * 64;
                    const bf16x8 vf = tr_frag(vp, vp + 8 * AT_VS); oa[db] = MFMA32(vf, pf, oa[db]); } }
        bf16* op = O + (size_t)(r0 + qs * 32 + l31) * D + hq * 64;
#pragma unroll
        for (int db = 0; db < 2; ++db)
#pragma unroll
            for (int g4 = 0; g4 < 4; ++g4) { v2u w; w.x = pk2(oa[db][4 * g4] * inv, oa[db][4 * g4 + 1] * inv); w.y = pk2(oa[db][4 * g4 + 2] * inv, oa[db][4 * g4 + 3] * inv); *(v2u*)(op + db * 32 + 8 * g4 + 4 * h) = w; }
#pragma unroll
        for (int ks = 0; ks < 4; ++ks) qf[ks] = qn[ks];
    }
}
__device__ __forceinline__ void attn_sample_unit(LAS unsigned char* lds, const bf16* Q, const bf16* Kb, const bf16* Vb, bf16* O, const float* sinks, const float* ck, const float* cv, float* wks, float* wvs, int sb, int hkv, int tid, int wave, int lane) {
    LAS float* Ks = (LAS float*)lds; LAS float* Vs = Ks + 128 * 65; LAS float* qs = Vs + 128 * 64; LAS float* sc = qs + 512;
    __syncthreads();
#pragma unroll 4
    for (int i = 0; i < 16; ++i) { const int idx = tid + 512 * i, j = idx >> 6, d = idx & 63; float kv, vv;
        if (j < 127) { const size_t g = ((size_t)(sb * 128 + j + 1) * 8 + hkv) * 64 + d; kv = ck[g]; vv = cv[g]; const size_t o = ((size_t)(sb * 128 + j) * 8 + hkv) * 64 + d; wks[o] = kv; wvs[o] = vv; }
        else { kv = bf2f(Kb[(size_t)(MP + sb) * KVD + hkv * 64 + d]); vv = bf2f(Vb[(size_t)(MP + sb) * KVD + hkv * 64 + d]); }
        Ks[j * 65 + d] = kv; Vs[j * 64 + d] = vv; }
    qs[tid] = bf2f(Q[(size_t)(MP + sb) * D + hkv * 512 + tid]);
    __syncthreads();
#pragma unroll
    for (int i = 0; i < 2; ++i) { const int idx = tid + 512 * i, g = idx >> 7, j = idx & 127; float s = 0.f;
#pragma unroll 16
        for (int d = 0; d < 64; ++d) s += qs[g * 64 + d] * Ks[j * 65 + d];
        sc[idx] = s * 0.125f; }
    __syncthreads();
    { const float snk = sinks[hkv * 8 + wave]; const float s0 = sc[wave * 128 + lane], s1 = sc[wave * 128 + 64 + lane];
      const float m = fmaxf(wave_max(fmaxf(s0, s1)), snk); const float e0 = __expf(s0 - m), e1 = __expf(s1 - m); const float den = wave_sum(e0 + e1) + __expf(snk - m);
      sc[wave * 128 + lane] = e0 / den; sc[wave * 128 + 64 + lane] = e1 / den; }
    __syncthreads();
    { const int g = tid >> 6, d = tid & 63; float o = 0.f;
#pragma unroll 16
      for (int j = 0; j < 128; ++j) o += sc[g * 128 + j] * Vs[j * 64 + d];
      O[(size_t)(MP + sb) * D + hkv * 512 + tid] = (bf16)(pk2(o, 0.f) & 0xffffu); }
}

__device__ __forceinline__ void quant_load(v4u (&x)[8], const bf16* src, int lane) {
#pragma unroll
    for (int i = 0; i < 8; ++i) x[i] = *(const v4u*)(src + (i * 64 + lane) * 8);
}
__device__ __forceinline__ void quant_finish(const v4u (&x)[8], signed char* dst, float* scale_out, float extra, int lane) {
    float amax = 0.f;
#pragma unroll
    for (int i = 0; i < 8; ++i) { const unsigned w_[4] = {x[i].x, x[i].y, x[i].z, x[i].w};
#pragma unroll
        for (int e = 0; e < 4; ++e) { amax = fmaxf(amax, fabsf(__builtin_bit_cast(float, w_[e] << 16))); amax = fmaxf(amax, fabsf(__builtin_bit_cast(float, w_[e] & 0xffff0000u))); } }
    amax = wave_max(amax);
    const float inv = amax > 0.f ? 127.0f / amax : 0.f;
#pragma unroll
    for (int i = 0; i < 8; ++i) { const unsigned w_[4] = {x[i].x, x[i].y, x[i].z, x[i].w}; unsigned q[2] = {0u, 0u};
#pragma unroll
        for (int e = 0; e < 4; ++e) { const int a = (int)__builtin_rintf(__builtin_bit_cast(float, w_[e] << 16) * inv), b = (int)__builtin_rintf(__builtin_bit_cast(float, w_[e] & 0xffff0000u) * inv);
            q[e >> 1] |= ((unsigned)(a & 255) | ((unsigned)(b & 255) << 8)) << (16 * (e & 1)); }
        *(v2u*)(dst + (i * 64 + lane) * 8) = (v2u){q[0], q[1]}; }
    if (lane == 0) *scale_out = amax * (1.0f / 127.0f) * extra;
}
__device__ __forceinline__ void quant_row_i8(const bf16* src, signed char* dst, float* scale_out, float extra, int lane) { v4u x[8]; quant_load(x, src, lane); quant_finish(x, dst, scale_out, extra, lane); }
template <class F> __device__ __forceinline__ void quant_rows_i8(int r0, int rend, int rstep, int lane, F f) {
    if (r0 >= rend) return;
    v4u xa[8], xb[8]; const bf16* src; signed char *da, *db; float *sa, *sb; float ea, eb;
    int r = r0; f(r, src, da, sa, ea); quant_load(xa, src, lane);
    for (;;) {
        const int r1 = r + rstep; const bool h1 = r1 < rend;
        if (h1) { f(r1, src, db, sb, eb); quant_load(xb, src, lane); }
        quant_finish(xa, da, sa, ea, lane);
        if (!h1) break;
        const int r2 = r1 + rstep; const bool h2 = r2 < rend;
        if (h2) { f(r2, src, da, sa, ea); quant_load(xa, src, lane); }
        quant_finish(xb, db, sb, eb, lane);
        if (!h2) break;
        r = r2;
    }
}

constexpr int GL_QT = 0, GL_KT = 17408, GL_KP = 34816, GL_V = 55296, GL_AM = 75776, GL_ST = 84992, GL_DEC = 119808, GL_PART = 120320, GL_END = 121344;
constexpr int GS_R = 272, GS_T = 320, GS_A = 144;
static_assert(GL_END <= RING_BYTES && GL_KT == 64 * GS_R && GL_KP == GL_KT + 64 * GS_R && GL_V == GL_KP + 64 * GS_T && GL_AM == GL_V + 64 * GS_T && GL_ST == GL_AM + 64 * GS_A && GL_DEC == GL_ST + 128 * GS_R, "GLA LDS map");
__device__ __forceinline__ void gla_prompt_seq(LAS unsigned char* lds, const bf16* QT, const bf16* KT, const bf16* VI, const bf16* GS, const float* DEC, const float* nw, bf16* OG, float* state_out,
                                               int b, int hh, int tid, int wave, int lane) {
    const int h = lane >> 5, l31 = lane & 31, i16 = lane & 15, q4 = i16 >> 2, p4 = i16 & 3, blk = (lane >> 4) & 1;
    const int kb = wave >> 1, vb0 = 2 * (wave & 1);
    const int tb = wave >> 2, vbo = wave & 3;
    __syncthreads();
    for (int i = tid * 16; i < GL_DEC - GL_AM; i += 512 * 16) *(LAS v4u*)(lds + GL_AM + i) = (v4u){0u, 0u, 0u, 0u};
    f32x16 S0, S1;
#pragma unroll
    for (int r = 0; r < 16; ++r) { S0[r] = 0.f; S1[r] = 0.f; }
    float nwv[16];
#pragma unroll
    for (int r = 0; r < 16; ++r) nwv[r] = nw[vbo * 32 + crow(r, h)];
    const int lrow0 = tid >> 4, lc16 = tid & 15; const int R0 = b * SEQ; const size_t gcol = (size_t)hh * 128 + lc16 * 8;
    v4u pqA[2], pkA[2], pvA[2], pqB[2], pkB[2], pvB[2]; float pdA = 0.f, pdB = 0.f; v2u gsE[4], gsO[4];
#define GLA_LOAD(X, c) do { if ((c) < 32) { _Pragma("unroll") for (int i_ = 0; i_ < 2; ++i_) { const size_t g_ = (size_t)(R0 + (c) * 64 + lrow0 + 32 * i_) * D + gcol; \
        pq##X[i_] = *(const v4u*)(QT + g_); pk##X[i_] = *(const v4u*)(KT + g_); pv##X[i_] = *(const v4u*)(VI + g_); } \
        if (tid < 128) pd##X = DEC[(size_t)(b * 32 + (c)) * D + hh * 128 + tid]; } } while (0)
#define GLA_STORE(X) do { _Pragma("unroll") for (int i_ = 0; i_ < 2; ++i_) { const int r_ = lrow0 + 32 * i_; \
        *(LAS v4u*)(lds + GL_QT + r_ * GS_R + lc16 * 16) = pq##X[i_]; *(LAS v4u*)(lds + GL_KT + r_ * GS_R + lc16 * 16) = pk##X[i_]; \
        *(LAS v4u*)(lds + GL_KP + r_ * GS_T + lc16 * 16) = pk##X[i_]; *(LAS v4u*)(lds + GL_V + r_ * GS_T + lc16 * 16) = pv##X[i_]; } \
        if (tid < 128) *(LAS float*)(lds + GL_DEC + tid * 4) = pd##X; } while (0)
#define GLA_GS(G, c) do { if ((c) < 32) { _Pragma("unroll") for (int g4_ = 0; g4_ < 4; ++g4_) G[g4_] = *(const v2u*)(GS + (size_t)(R0 + (c) * 64 + tb * 32 + l31) * D + hh * 128 + vbo * 32 + 8 * g4_ + 4 * h); } } while (0)
#define GLA_CHUNK(c, X, G) do { \
        LDS_BARRIER();                                                     \
        const int trow = R0 + (c) * 64 + tb * 32 + l31; \
        { bf16x8 kpf[4], vf0[4], vf1[4];                                     \
          _Pragma("unroll") for (int ts = 0; ts < 4; ++ts) { const int t0 = 16 * ts + 8 * h + q4; \
            const LAS unsigned char* ka = lds + GL_KP + t0 * GS_T + (kb * 32 + 16 * blk) * 2 + 8 * p4; kpf[ts] = tr_frag(ka, ka + 4 * GS_T); \
            const LAS unsigned char* va = lds + GL_V + t0 * GS_T + (vb0 * 32 + 16 * blk) * 2 + 8 * p4; vf0[ts] = tr_frag(va, va + 4 * GS_T); vf1[ts] = tr_frag(va + 64, va + 64 + 4 * GS_T); } \
          _Pragma("unroll") for (int ts = 0; ts < 4; ++ts) { S0 = MFMA32(kpf[ts], vf0[ts], S0); S1 = MFMA32(kpf[ts], vf1[ts], S1); } } \
        _Pragma("unroll") for (int r = 0; r < 16; ++r) { const float dc = *(const LAS float*)(lds + GL_DEC + (kb * 32 + crow(r, h)) * 4); S0[r] *= dc; S1[r] *= dc; }     \
        if (wave < 3) { const int tbp = wave > 0 ? 1 : 0, sb = wave == 2 ? 1 : 0; f32x16 a; \
            _Pragma("unroll") for (int r = 0; r < 16; ++r) a[r] = 0.f; \
            bf16x8 kf[8], qf[8]; \
            _Pragma("unroll") for (int ks = 0; ks < 8; ++ks) { kf[ks] = *(const LAS bf16x8*)(lds + GL_KT + (sb * 32 + l31) * GS_R + (ks * 16 + 8 * h) * 2); qf[ks] = *(const LAS bf16x8*)(lds + GL_QT + (tbp * 32 + l31) * GS_R + (ks * 16 + 8 * h) * 2); } \
            _Pragma("unroll") for (int ks = 0; ks < 8; ++ks) a = MFMA32(kf[ks], qf[ks], a); \
            const int t_ = tbp * 32 + l31; \
            _Pragma("unroll") for (int g4 = 0; g4 < 4; ++g4) { float x[4]; \
                _Pragma("unroll") for (int j = 0; j < 4; ++j) { const int sp = sb * 32 + 8 * g4 + 4 * h + j; x[j] = (sp <= t_) ? a[4 * g4 + j] : 0.f; } \
                v2u w; w.x = pk2(x[0], x[1]); w.y = pk2(x[2], x[3]); *(LAS v2u*)(lds + GL_AM + t_ * GS_A + (sb * 32 + 8 * g4 + 4 * h) * 2) = w; } } \
        LDS_BARRIER();                                                     \
        f32x16 o; \
        _Pragma("unroll") for (int r = 0; r < 16; ++r) o[r] = 0.f; \
        const int t = tb * 32 + l31; \
        { bf16x8 sf[8], qf[8], vf[4], af[4]; \
          _Pragma("unroll") for (int ks = 0; ks < 8; ++ks) { sf[ks] = *(const LAS bf16x8*)(lds + GL_ST + (vbo * 32 + l31) * GS_R + (ks * 16 + 8 * h) * 2); qf[ks] = *(const LAS bf16x8*)(lds + GL_QT + t * GS_R + (ks * 16 + 8 * h) * 2); } \
          _Pragma("unroll") for (int ks = 0; ks < 4; ++ks) { const LAS unsigned char* va = lds + GL_V + (16 * ks + 8 * h + q4) * GS_T + (vbo * 32 + 16 * blk) * 2 + 8 * p4; vf[ks] = tr_frag(va, va + 4 * GS_T); \
            af[ks] = *(const LAS bf16x8*)(lds + GL_AM + t * GS_A + (ks * 16 + 8 * h) * 2); } \
          _Pragma("unroll") for (int ks = 0; ks < 8; ++ks) o = MFMA32(sf[ks], qf[ks], o); \
          _Pragma("unroll") for (int ks = 0; ks < 4; ++ks) o = MFMA32(vf[ks], af[ks], o); } \
        float sq = 0.f; \
        _Pragma("unroll") for (int r = 0; r < 16; ++r) sq += o[r] * o[r]; \
        sq += __shfl_xor(sq, 32); \
        if (h == 0) *(LAS float*)(lds + GL_PART + (vbo * 64 + t) * 4) = sq; \
        LDS_BARRIER();                                                     \
        { const LAS float* pp_ = (const LAS float*)(lds + GL_PART); const float tot = (pp_[t] + pp_[64 + t]) + (pp_[128 + t] + pp_[192 + t]); const float rstd = __builtin_amdgcn_rsqf(tot * (1.0f / 128.0f) + RMS_EPS); \
          _Pragma("unroll") for (int g4 = 0; g4 < 4; ++g4) { const float g0 = __builtin_bit_cast(float, G[g4].x << 16), g1 = __builtin_bit_cast(float, G[g4].x & 0xffff0000u), g2 = __builtin_bit_cast(float, G[g4].y << 16), g3 = __builtin_bit_cast(float, G[g4].y & 0xffff0000u); \
              v2u w; w.x = pk2(o[4 * g4] * rstd * nwv[4 * g4] * g0, o[4 * g4 + 1] * rstd * nwv[4 * g4 + 1] * g1); w.y = pk2(o[4 * g4 + 2] * rstd * nwv[4 * g4 + 2] * g2, o[4 * g4 + 3] * rstd * nwv[4 * g4 + 3] * g3); \
              *(v2u*)(OG + (size_t)trow * D + hh * 128 + vbo * 32 + 8 * g4 + 4 * h) = w; } } \
        _Pragma("unroll") for (int g4 = 0; g4 < 4; ++g4) { v2u w0, w1; w0.x = pk2(S0[4 * g4], S0[4 * g4 + 1]); w0.y = pk2(S0[4 * g4 + 2], S0[4 * g4 + 3]); w1.x = pk2(S1[4 * g4], S1[4 * g4 + 1]); w1.y = pk2(S1[4 * g4 + 2], S1[4 * g4 + 3]); \
            *(LAS v2u*)(lds + GL_ST + (vb0 * 32 + l31) * GS_R + (kb * 32 + 8 * g4 + 4 * h) * 2) = w0; *(LAS v2u*)(lds + GL_ST + ((vb0 + 1) * 32 + l31) * GS_R + (kb * 32 + 8 * g4 + 4 * h) * 2) = w1; } \
        if ((c) + 1 < 32) GLA_STORE(X); \
        GLA_LOAD(X, (c) + 3); GLA_GS(G, (c) + 2); \
    } while (0)
    GLA_LOAD(B, 0); GLA_STORE(B);
    GLA_LOAD(A, 1); GLA_LOAD(B, 2); GLA_GS(gsE, 0); GLA_GS(gsO, 1);
    for (int c = 0; c < 32; c += 2) {
        GLA_CHUNK(c, A, gsE);
        GLA_CHUNK(c + 1, B, gsO);
    }
#undef GLA_LOAD
#undef GLA_STORE
#undef GLA_GS
#undef GLA_CHUNK
    float* so = state_out + ((size_t)(b * 32 + hh) * 128 + kb * 32) * 128 + vb0 * 32 + l31;
#pragma unroll
    for (int r = 0; r < 16; ++r) { so[(size_t)crow(r, h) * 128] = S0[r]; so[(size_t)crow(r, h) * 128 + 32] = S1[r]; }
}
__device__ __forceinline__ void gla_sample_unit(LAS unsigned char* lds, const float* sraw, const float* st_in, const float* lb, const float* nw, bf16* OG, float* st_out, int sb, int hh, int tid, int wave, int lane) {
    LAS float* fk = (LAS float*)lds; LAS float* kk = fk + 128; LAS float* qv = kk + 128; LAS float* iv = qv + 128; LAS float* part = iv + 128; LAS float* red = part + 512;
    __syncthreads();
    const float* sr = sraw + (size_t)sb * NHG + hh * 128;
    if (tid < 128) { const float q = sr[tid], f = sr[D + tid], x = sr[2 * D + tid]; const float l = lb[hh * 128 + tid]; const float k1 = (1.0f - l) * fast_rcp(1.0f + __expf(f));
        fk[tid] = 1.0f - k1; kk[tid] = k1; qv[tid] = siluf_(q) * 0.08838834764831845f; iv[tid] = x; }
    __syncthreads();
    const int v = tid & 127, kg = tid >> 7; const size_t base = ((size_t)(sb * 32 + hh) * 128 + kg * 32) * 128 + v; const float xi = iv[v]; float op = 0.f;
    float s0v[32];
#pragma unroll
    for (int k = 0; k < 32; ++k) s0v[k] = __builtin_nontemporal_load(st_in + base + (size_t)k * 128);
#pragma unroll
    for (int k = 0; k < 32; ++k) { const float s = fk[kg * 32 + k] * s0v[k] + kk[kg * 32 + k] * xi; __builtin_nontemporal_store(s, st_out + base + (size_t)k * 128); op += qv[kg * 32 + k] * s; }
    part[kg * 128 + v] = op;
    __syncthreads();
    float o = 0.f;
    if (tid < 128) { o = (part[tid] + part[128 + tid]) + (part[256 + tid] + part[384 + tid]); const float ws = wave_sum(o * o); if (lane == 0) red[wave] = ws; }
    __syncthreads();
    if (tid < 128) { const float rstd = __builtin_amdgcn_rsqf((red[0] + red[1]) * (1.0f / 128.0f) + RMS_EPS); const float g = sr[3 * D + tid];
        OG[(size_t)(MP + sb) * D + hh * 128 + tid] = (bf16)(pk2(o * rstd * nw[tid] * siluf_(g), 0.f) & 0xffffu); }
}

struct Args { const float* in[19]; float* out; unsigned char* ws; int ph_lo, ph_hi, li, pad; };
enum { I_XP = 0, I_XS, I_CK, I_CV, I_ST, I_NMIX, I_NFFN, I_NFIN, I_WQKV, I_BQKV, I_SINK, I_WO, I_BO, I_HWIN, I_HLB, I_HNORM, I_HWO, I_FWIN, I_FWOUT };

template <class Epi, bool I8 = false> __device__ __forceinline__ void run_gemm(LAS unsigned char* lds, const bf16* A, const bf16* Bt, int N, int K, const Epi& E, int Gn = (int)gridDim.x, int cn = (int)blockIdx.x, int nx = pg8::NXCD) {
    pg8::Gemm g{A, Bt, MP, N, K}; pg8::StaticOrder S; S.init(MP, N, Gn, cn, nx);
    pg8::gemm_phase<Epi, pg8::StaticOrder, true, true, I8>(lds, g, S, E);
}
__device__ __forceinline__ void sample_deal(int nwg, int& u0, int& ustep) { const int G = (int)gridDim.x, first = nwg % G; if (first == 0) { u0 = (int)blockIdx.x; ustep = G; } else { u0 = (int)blockIdx.x >= first ? (int)blockIdx.x - first : (1 << 30); ustep = G - first; } }
__device__ __forceinline__ void sample_res(LAS unsigned char* lds, const bf16* A, int K, const bf16* Bt, bf16* xb, float* out, const float* bias, ssq_t* ss, int tid, int wave, int lane) {
    const int row = tid >> 4, n = tid & 15;
    SampleA sa; const bool resident = (K == D) && (int)blockIdx.x < D / 16; if (resident) sample_load_a(sa, A, wave, lane);
    for (int u = blockIdx.x; u < D / 16; u += gridDim.x) { float r[1];
        if (K == D) sgemm_unit_ra<1>(sa, Bt + (size_t)u * 16 * K, Bt + (size_t)u * 16 * K, (LAS float*)lds, wave, lane, tid, r); else sgemm_unit<1>(A, K, Bt + (size_t)u * 16 * K, Bt + (size_t)u * 16 * K, (LAS float*)lds, wave, lane, tid, r);
        const int col = u * 16 + n; const size_t off = (size_t)row * D + col; float x = bf2f(xb[off]) + r[0] + (bias ? bias[col] : 0.f);
        if (out) out[off] = x; else { const bf16 xr = (bf16)(pk2(x, 0.f) & 0xffffu); xb[off] = xr; x = bf2f(xr); }
        float sq = x * x; sq += __shfl_xor(sq, 1); sq += __shfl_xor(sq, 2); sq += __shfl_xor(sq, 4); sq += __shfl_xor(sq, 8);
        if (n == 0) __hip_atomic_fetch_add(ss + row, ss_fix(sq), RLX_AGENT); }
}
__device__ __forceinline__ void sample_res_ksplit(LAS unsigned char* lds, volatile LAS unsigned* flagw, const bf16* A, const bf16* Bt, bf16* xb, ssq_t* ss, float* part, unsigned* cnt, int tid, int wave, int lane) {
    constexpr int KC = DFF / 8, NST = KC / 32;
    static_assert(KC * 8 == DFF && NST * 32 == KC, "K-chunks of whole 32-k steps");
    const int bx = (int)blockIdx.x, kc = bx & 7, nb = bx >> 3, fr = lane & 15, fq = lane >> 4;
    constexpr int NFW = (2 * NST + NWAVES - 1) / NWAVES; v4u af[NFW];
#pragma unroll
    for (int i = 0; i < NFW; ++i) { const int f = wave + i * NWAVES, fc = f < 2 * NST ? f : 0, t = fc >> 1, h = fc & 1;
        af[i] = *(const v4u*)(A + (size_t)(16 * h + fr) * DFF + kc * KC + t * 32 + fq * 8); }
    const bf16* bp = Bt + (size_t)(nb * 128 + wave * 16 + fr) * DFF + kc * KC + fq * 8;
    bf16x8 b[NST];
#pragma unroll
    for (int t = 0; t < NST / 2; ++t) b[t] = *(const bf16x8*)(bp + t * 32);
#pragma unroll
    for (int i = 0; i < NFW; ++i) { const int f = wave + i * NWAVES; if (f < 2 * NST) *(LAS v4u*)(lds + f * 1024 + lane * 16) = af[i]; }
#pragma unroll
    for (int t = NST / 2; t < NST; ++t) b[t] = *(const bf16x8*)(bp + t * 32);
    __syncthreads();
    f32x4 c0 = (f32x4){0.f, 0.f, 0.f, 0.f}, c1 = (f32x4){0.f, 0.f, 0.f, 0.f};
#pragma unroll
    for (int t = 0; t < NST; ++t) { const bf16x8 a0 = *(const LAS bf16x8*)(lds + (2 * t) * 1024 + lane * 16), a1 = *(const LAS bf16x8*)(lds + (2 * t + 1) * 1024 + lane * 16);
        c0 = MFMA16(b[t], a0, c0); c1 = MFMA16(b[t], a1, c1); }
    { float* pp = part + ((size_t)kc * MS + fr) * D + nb * 128 + wave * 16 + 4 * fq; *(f32x4*)pp = c0; *(f32x4*)(pp + (size_t)16 * D) = c1; }
    asm volatile("s_waitcnt vmcnt(0)" ::: "memory");
    __syncthreads();
    if (tid == 0) { __builtin_amdgcn_fence(__ATOMIC_RELEASE, "agent"); asm volatile("s_waitcnt vmcnt(0)" ::: "memory");
        const unsigned old = xb_add(cnt + nb, 1u); unsigned last = 0u;
        if (old == 7u) { __builtin_amdgcn_fence(__ATOMIC_ACQUIRE, "agent"); asm volatile("s_waitcnt vmcnt(0)" ::: "memory"); last = 1u; }
        *flagw = last; }
    __syncthreads();
    if (*flagw) {
        const int row = tid >> 4, c8 = nb * 128 + (tid & 15) * 8; f32x4 s0 = (f32x4){0.f, 0.f, 0.f, 0.f}, s1 = s0;
#pragma unroll
        for (int k = 0; k < 8; ++k) { const float* pp = part + ((size_t)k * MS + row) * D + c8; s0 += *(const f32x4*)pp; s1 += *(const f32x4*)(pp + 4); }
        const v4u xr = *(const v4u*)(xb + (size_t)row * D + c8); const unsigned xw_[4] = {xr.x, xr.y, xr.z, xr.w}; float o[8];
#pragma unroll
        for (int e = 0; e < 8; ++e) { const float xv = __builtin_bit_cast(float, (e & 1) ? (xw_[e >> 1] & 0xffff0000u) : (xw_[e >> 1] << 16)); o[e] = xv + (e < 4 ? s0[e & 3] : s1[e & 3]); }
        v4u w; w.x = pk2(o[0], o[1]); w.y = pk2(o[2], o[3]); w.z = pk2(o[4], o[5]); w.w = pk2(o[6], o[7]); *(v4u*)(xb + (size_t)row * D + c8) = w;
        const unsigned ww_[4] = {w.x, w.y, w.z, w.w}; float sq = 0.f;
#pragma unroll
        for (int e = 0; e < 8; ++e) { const float xv = __builtin_bit_cast(float, (e & 1) ? (ww_[e >> 1] & 0xffff0000u) : (ww_[e >> 1] << 16)); sq += xv * xv; }
        sq += __shfl_xor(sq, 1); sq += __shfl_xor(sq, 2); sq += __shfl_xor(sq, 4); sq += __shfl_xor(sq, 8);
        if ((tid & 15) == 0) __hip_atomic_fetch_add(ss + row, ss_fix(sq), RLX_AGENT);
    }
    __syncthreads();
}
#ifndef FFI_IDLE_UNITS
#define FFI_IDLE_UNITS 5
#endif
__device__ __forceinline__ void sample_ffn_in(LAS unsigned char* lds, const bf16* A, const bf16* Bt, bf16* H, const ssq_t* ss, int tid, int wave, int lane) {
    const int row = tid >> 4, n = tid & 15;
    const int Gs = (int)gridDim.x, first = ((MP / 256) * (NFI / 256)) % Gs, nidle = first ? Gs - first : 0, nfast = nidle * FFI_IDLE_UNITS < DFF / 16 ? nidle * FFI_IDLE_UNITS : 0;
    int su0, sus, suend;
    if (nfast && (int)blockIdx.x >= first) { su0 = (int)blockIdx.x - first; sus = nidle; suend = nfast; } else if (nfast) { su0 = nfast + (int)blockIdx.x; sus = first; suend = DFF / 16; } else { su0 = (int)blockIdx.x; sus = Gs; suend = DFF / 16; }
    SampleA sa; if (su0 < suend) sample_load_a(sa, A, wave, lane);
    for (int u = su0; u < suend; u += sus) { const int j0 = u * 16; const bf16* bg = Bt + (size_t)(256 * (j0 >> 7) + (j0 & 127)) * D; float r[2];
        sgemm_unit_ra<2>(sa, bg, bg + (size_t)128 * D, (LAS float*)lds, wave, lane, tid, r);
        const float rs = ss_rstd(ss, row); H[(size_t)row * DFF + j0 + n] = (bf16)(pk2(siluf_(r[0] * rs) * (r[1] * rs), 0.f) & 0xffffu); }
}

__device__ __forceinline__ void sample_ffn_in_q(LAS unsigned char* lds, const signed char* A8, const signed char* Bq, bf16* H, const float* ra, const float* bs, int tid, int wave, int lane) {
    const int row = tid >> 4, n = tid & 15;
    const int Gs = (int)gridDim.x, first = ((MP / 256) * (NFI / 256)) % Gs, nidle = first ? Gs - first : 0, nfast = nidle * FFI_IDLE_UNITS < DFF / 16 ? nidle * FFI_IDLE_UNITS : 0;
    int su0, sus, suend;
    if (nfast && (int)blockIdx.x >= first) { su0 = (int)blockIdx.x - first; sus = nidle; suend = nfast; } else if (nfast) { su0 = nfast + (int)blockIdx.x; sus = first; suend = DFF / 16; } else { su0 = (int)blockIdx.x; sus = Gs; suend = DFF / 16; }
    SampleA8 sa; if (su0 < suend) sample_load_a8(sa, A8, wave, lane);
    const float rs = ra[row];
    for (int u = su0; u < suend; u += sus) { const int j0 = u * 16, wr0 = 256 * (j0 >> 7) + (j0 & 127); const signed char* bg = Bq + (size_t)wr0 * D; float r[2];
        sgemm_unit_i8x2(sa, bg, bg + (size_t)128 * D, (LAS float*)lds, wave, lane, tid, r);
        H[(size_t)row * DFF + j0 + n] = (bf16)(pk2(siluf_(r[0] * (rs * bs[wr0 + n])) * (r[1] * (rs * bs[wr0 + 128 + n])), 0.f) & 0xffffu); }
}

#define PTR64(k) ({ const unsigned long long v_ = ptab[k]; ((unsigned long long)(unsigned)__builtin_amdgcn_readfirstlane((int)(v_ >> 32)) << 32) | (unsigned)__builtin_amdgcn_readfirstlane((int)v_); })
#define PIN(k) ((const float*)(const GAS float*)PTR64(k))
constexpr int CI0 = (D / 64) * (QKVN / 32), CI1 = (D / 64) * (D / 32), CI2 = (D / 64) * (NFI / 32), CI3 = (DFF / 64) * (D / 32), CI4 = (D / 64) * (NHG / 32);
constexpr int CO_WO = CI0, CO_FI0 = CO_WO + CI1, CO_FO0 = CO_FI0 + CI2, CO_HI = CO_FO0 + CI3, CO_HO = CO_HI + CI4, CO_FI1 = CO_HO + CI1, CO_FO1 = CO_FI1 + CI2, CO_END = CO_FO1 + CI3;
__device__ __forceinline__ CvItem cv_lookup(volatile LAS unsigned long long* ptab, int it) {
    unsigned char* ws = (unsigned char*)(GAS unsigned char*)PTR64(20); CvItem c; int r = it;
    if (r < CO_WO)       { c.W = PIN(I_WQKV); c.K = D; c.N = QKVN; c.WT = (bf16*)(ws + WS_WQKV); c.map = 0; c.kw = PIN(I_NMIX); }
    else if (r < CO_FI0) { r -= CO_WO;  c.W = PIN(I_WO); c.K = D; c.N = D; c.WT = (bf16*)(ws + WS_WO); c.map = 0; c.kw = nullptr; }
    else if (r < CO_FO0) { r -= CO_FI0; c.W = PIN(I_FWIN); c.K = D; c.N = NFI; c.WT = (bf16*)(ws + WS_WFI0); c.map = 1; c.kw = PIN(I_NFFN); }
    else if (r < CO_HI)  { r -= CO_FO0; c.W = PIN(I_FWOUT); c.K = DFF; c.N = D; c.WT = (bf16*)(ws + WS_WFO0); c.map = 0; c.kw = nullptr; }
    else if (r < CO_HO)  { r -= CO_HI;  c.W = PIN(I_HWIN); c.K = D; c.N = NHG; c.WT = (bf16*)(ws + WS_WHI); c.map = 2; c.kw = PIN(I_NMIX) + D; }
    else if (r < CO_FI1) { r -= CO_HO;  c.W = PIN(I_HWO); c.K = D; c.N = D; c.WT = (bf16*)(ws + WS_WHO); c.map = 0; c.kw = nullptr; }
    else if (r < CO_FO1) { r -= CO_FI1; c.W = PIN(I_FWIN) + (size_t)D * NFI; c.K = D; c.N = NFI; c.WT = (bf16*)(ws + WS_WFI1); c.map = 1; c.kw = PIN(I_NFFN) + D; }
    else                 { r -= CO_FO1; c.W = PIN(I_FWOUT) + (size_t)DFF * D; c.K = DFF; c.N = D; c.WT = (bf16*)(ws + WS_WFO1); c.map = 0; c.kw = nullptr; }
    c.item = r; return c;
}
__device__ __forceinline__ void convert_items(volatile LAS unsigned long long* ptab, int lo, int hi, int worker, int nworkers, LAS float* scr, int lane) {
    for (int it = lo + worker; it < hi; it += 2 * nworkers) {
        const bool two = it + nworkers < hi;
        const CvItem ca = cv_lookup(ptab, it), cb = cv_lookup(ptab, two ? it + nworkers : it);
        float va[32], vb[32], ka, kb_;
        cv_load(ca, lane, va, ka);
        if (two) cv_load(cb, lane, vb, kb_);
        cv_store(ca, lane, va, ka, scr);
        if (two) cv_store(cb, lane, vb, kb_, scr);
    }
}
#ifndef CV_S7
#define CV_S7 8192
#endif
constexpr int S7_LO = CO_HO, S7_HI = CO_HO + CV_S7;
static_assert(S7_HI <= CO_FO1, "the P7 slot holds only weights that are first used after P7");
#ifndef CV_SPLIT
#define CV_SPLIT CO_WO
#endif
static_assert(CV_SPLIT >= CO_WO && (CV_SPLIT <= S7_LO || CV_SPLIT >= S7_HI), "P0 converts items [0, CV_SPLIT), P1's conversion half the rest");

__global__ void __launch_bounds__(NWAVES * 64, 2) fwd_kernel(Args args) {
    extern __shared__ __attribute__((aligned(16))) unsigned char lds_raw[];
    LAS unsigned char* lds = (LAS unsigned char*)lds_raw;
    volatile LAS unsigned* MISC = (volatile LAS unsigned*)(lds + MISC_OFF);
    const int tid = threadIdx.x, lane = tid & 63, wave = __builtin_amdgcn_readfirstlane(tid >> 6);
    const int G = gridDim.x; const int bx = blockIdx.x; const int vcu = (G % 8 == 0) ? (bx % 8) * (G / 8) + bx / 8 : bx;
    unsigned char* ws = args.ws;
    gu32* ctl = (gu32*)(ws + WS_CTL);
    for (int u = tid; u < (LDS_BYTES - LDSCTL_OFF) / 4; u += NWAVES * 64) ((LAS unsigned*)(lds + LDSCTL_OFF))[u] = 0u;
    __syncthreads();
    volatile LAS unsigned long long* ptab = (volatile LAS unsigned long long*)(lds + PTAB_OFF);
    if (tid == 0) {
#pragma unroll
        for (int k = 0; k < 19; ++k) ptab[k] = (unsigned long long)args.in[k];
        ptab[19] = (unsigned long long)args.out; ptab[20] = (unsigned long long)args.ws; }
    __syncthreads();
    XcdBarrier bar; bar.bar = (unsigned*)(ctl + CW_BAR); bar.x = 0; bar.st = nullptr;
    if (N_LAUNCHES == 1) bar = xcd_barrier_post((unsigned*)(ctl + CW_BAR), MISC + 8);
#define GRID_BAR() do { if (N_LAUNCHES == 1) xcd_barrier(bar); } while (0)
    const int lo = args.ph_lo, hi = args.ph_hi;
#ifdef ONLY_PHASE
#define IN(k) ((k) == ONLY_PHASE && lo <= (k) && (k) < hi)
#else
#define IN(k) (lo <= (k) && (k) < hi)
#endif
#define BOTH(k) (IN(k) && IN((k) + 1))
#ifndef REPMASK
#define REPMASK 0
#endif
#ifndef REPN
#define REPN 1
#endif
#define REPEAT(k) for (int rep_ = 0; rep_ < (((REPMASK) >> (k)) & 1) * (REPN) + 1; ++rep_)
#define WSB ((unsigned char*)(GAS unsigned char*)PTR64(20))
#define WQKV ((bf16*)(WSB + WS_WQKV))
#define WO ((bf16*)(WSB + WS_WO))
#define WFI0 ((bf16*)(WSB + WS_WFI0))
#define WFO0 ((bf16*)(WSB + WS_WFO0))
#define WHI ((bf16*)(WSB + WS_WHI))
#define WHO ((bf16*)(WSB + WS_WHO))
#define WFI1 ((bf16*)(WSB + WS_WFI1))
#define WFO1 ((bf16*)(WSB + WS_WFO1))
#define XB ((bf16*)(WSB + WS_XN))
#define Qb ((bf16*)(WSB + WS_Q))
#define Kb ((bf16*)(WSB + WS_K))
#define Vb ((bf16*)(WSB + WS_V))
#define Ob ((bf16*)(WSB + WS_O))
#define Hb ((bf16*)(WSB + WS_H))
#define QT ((bf16*)(WSB + WS_QT))
#define KT ((bf16*)(WSB + WS_KT))
#define KP ((bf16*)(WSB + WS_KP))
#define VI ((bf16*)(WSB + WS_VI))
#define GSb ((bf16*)(WSB + WS_GS))
#define DEC ((float*)(WSB + WS_DEC))
#define SRAW ((float*)(WSB + WS_SRAW))
#define LB ((float*)(WSB + WS_LB))
#define XQ ((signed char*)(WSB + WS_XQ))
#define XQS ((signed char*)(WSB + WS_RA + 65536))
#define RA ((float*)(WSB + WS_RA))
#define WQ1 ((signed char*)(WSB + WS_WQ1))
#define BSC ((float*)(WSB + WS_BSC))
#define WQ0 ((signed char*)(WSB + WS_WQ0))
#define WQO ((signed char*)(WSB + WS_WQO))
#define WQQ ((signed char*)(WSB + WS_WQQ))
#define BSCQ ((float*)(WSB + WS_BSCQ))
#define BSCO ((float*)(WSB + WS_BSCO))
#define BSC0 ((float*)(WSB + WS_BSC0))
#define SSB(k) ((ssq_t*)(WSB + WS_CTL + CW_SS * 4) + (k) * SS_STRIDE)
#define SS0 SSB(0)
#define SS1 SSB(1)
#define SS2 SSB(2)
#define SS3 SSB(3)
#define SS4 SSB(4)
#define out ((float*)(GAS float*)PTR64(19))

    if (IN(0)) REPEAT(0) {
        LAS float* scr = (LAS float*)(lds + RING_OFF + wave * 16384);
        const int gw = vcu * NWAVES + wave, NGW = G * NWAVES;
        convert_items(ptab, 0, CV_SPLIT < S7_LO ? CV_SPLIT : S7_LO, gw, NGW, scr, lane);
        if (CV_SPLIT > S7_HI) convert_items(ptab, S7_HI, CV_SPLIT, gw, NGW, scr, lane);
        for (int m = gw; m < MT; m += NGW) row_to_bf16_ss(m < MP ? PIN(I_XP) + (size_t)m * D : PIN(I_XS) + (size_t)(m - MP) * D, XB + (size_t)m * D, SS0 + m, lane, m < MP ? XQ + (size_t)m * D : nullptr, RA + (m < MP ? m : 0));
        if (bx == 0) for (int c = tid; c < D; c += NWAVES * 64) LB[c] = fast_rcp(1.0f + __expf(PIN(I_HLB)[c] - PIN(I_HLB)[D + c]));
        if (BOTH(0)) GRID_BAR();
    }
    if (IN(1)) REPEAT(1) {
        const int GH = G / 2; const bool gemm_side = (bx & 1) == 0; const int hidx = ((bx & 7) >> 1) + 4 * (bx >> 3);
        if (gemm_side) {
            unsigned* sideA = (unsigned*)(ctl + CW_SIDE_A); unsigned* tmo = (unsigned*)(ctl + CW_BAR) + XB_TMO;
            quant_rows_i8(hidx * NWAVES + wave, D, GH * NWAVES, lane, [&](int r, const bf16*& sp, signed char*& dp, float*& sc, float& ex) { sp = WQKV + (size_t)r * D; dp = WQQ + (size_t)r * D; sc = BSCQ + r; ex = 1.0f; });
            side_barrier(sideA, GH, tmo);
            { EpiQKVT<true> E{Qb, Kb, Vb, PIN(I_BQKV), out + OUT_WKP, out + OUT_WVP, SS0, RA, BSCQ, 0}; run_gemm<EpiQKVT<true>, true>(lds + RING_OFF, (const bf16*)XQ, (const bf16*)WQQ, D, D / 2, E, GH, hidx, 4); }
            { EpiQKVT<false> E{Qb, Kb, Vb, PIN(I_BQKV), out + OUT_WKP, out + OUT_WVP, SS0, nullptr, nullptr, 16}; run_gemm(lds + RING_OFF, XB, WQKV + (size_t)D * D, 2 * KVD, D, E, GH, hidx, 4); }
            const int row = tid >> 4, n = tid & 15;
            SampleA sa; if (hidx < QKVN / 16) sample_load_a(sa, XB + (size_t)MP * D, wave, lane);
            for (int u = hidx; u < QKVN / 16; u += GH) { float r[1]; sgemm_unit_ra<1>(sa, WQKV + (size_t)u * 16 * D, WQKV + (size_t)u * 16 * D, (LAS float*)lds, wave, lane, tid, r);
                const int col = u * 16 + n; const float v = r[0] * ss_rstd(SS0, MP + row) + PIN(I_BQKV)[col]; const bf16 vb = (bf16)(pk2(v, 0.f) & 0xffffu);
                if (col < D) Qb[(size_t)(MP + row) * D + col] = vb;
                else if (col < D + KVD) { Kb[(size_t)(MP + row) * KVD + col - D] = vb; out[OUT_WKS + ((size_t)row * 128 + 127) * KVD + col - D] = v; }
                else { Vb[(size_t)(MP + row) * KVD + col - D - KVD] = vb; out[OUT_WVS + ((size_t)row * 128 + 127) * KVD + col - D - KVD] = v; } }
            side_barrier(sideA, 2 * GH, tmo);
            { AttnKV kv; if (hidx < NBATCH * 16 * 8) attn_kv_load(kv, Kb, Vb, hidx >> 7, hidx & 7, (hidx >> 3) & 15, tid);
              for (int u = hidx; u < NBATCH * 16 * 8; u += GH) { const int hkv = u & 7, n = (u >> 3) & 15, b = u >> 7; const int un = u + GH; const bool hn = un < NBATCH * 16 * 8;
                  attn_prompt_unit(lds + RING_OFF, Qb, Kb, Vb, Ob, PIN(I_SINK), b, hkv, n, kv, hn, un >> 7, un & 7, (un >> 3) & 15, tid, wave, lane); } }
            for (int u = hidx; u < MS * 8; u += GH) attn_sample_unit(lds + RING_OFF, Qb, Kb, Vb, Ob, PIN(I_SINK), PIN(I_CK), PIN(I_CV), out + OUT_WKS, out + OUT_WVS, u >> 3, u & 7, tid, wave, lane);
            side_barrier(sideA, 3 * GH, tmo);
            quant_rows_i8(hidx * NWAVES + wave, MP, GH * NWAVES, lane, [&](int r, const bf16*& sp, signed char*& dp, float*& sc, float& ex) { sp = Ob + (size_t)r * D; dp = XQ + (size_t)r * D; sc = RA + r; ex = 1.0f; });
        } else {
            LAS float* scr = (LAS float*)(lds + RING_OFF + wave * 16384); const int wk = hidx * NWAVES + wave, nwk = (G - GH) * NWAVES;
            if (CV_SPLIT < S7_LO) convert_items(ptab, CV_SPLIT, S7_LO, wk, nwk, scr, lane);
            convert_items(ptab, CV_SPLIT > S7_HI ? CV_SPLIT : S7_HI, CO_END, wk, nwk, scr, lane);
        }
        if (BOTH(1)) GRID_BAR();
    }
    if (IN(2)) REPEAT(2) {
        quant_rows_i8(vcu * NWAVES + wave, NFI, G * NWAVES, lane, [&](int r, const bf16*& sp, signed char*& dp, float*& sc, float& ex) { sp = WFI0 + (size_t)r * D; dp = WQ0 + (size_t)r * D; sc = BSC0 + r; ex = 1.0f; });
        quant_rows_i8(vcu * NWAVES + wave, D, G * NWAVES, lane, [&](int r, const bf16*& sp, signed char*& dp, float*& sc, float& ex) { sp = WO + (size_t)r * D; dp = WQO + (size_t)r * D; sc = BSCO + r; ex = 1.0f; });
        __syncthreads();
        if (BOTH(2)) GRID_BAR();
    }
    if (IN(3)) {
        { EpiResT<true> E{XB, nullptr, PIN(I_BO), SS1, RA, BSCO}; run_gemm<EpiResT<true>, true>(lds + RING_OFF, (const bf16*)XQ, (const bf16*)WQO, D, D / 2, E); }
        sample_res(lds + RING_OFF, Ob + (size_t)MP * D, D, WO, XB + (size_t)MP * D, nullptr, PIN(I_BO), SS1 + MP, tid, wave, lane);
        if (BOTH(3)) GRID_BAR();
    }
    if (IN(4)) REPEAT(4) {
        quant_rows_i8(vcu * NWAVES + wave, MT, G * NWAVES, lane, [&](int r, const bf16*& sp, signed char*& dp, float*& sc, float& ex) { sp = XB + (size_t)r * D; dp = r < MP ? XQ + (size_t)r * D : XQS + (size_t)(r - MP) * D; sc = RA + r; ex = ss_rstd(SS1, r); });
        GRID_BAR();
        { EpiSwiGLUQ E{Hb, RA, BSC0}; run_gemm<EpiSwiGLUQ, true>(lds + RING_OFF, (const bf16*)XQ, (const bf16*)WQ0, NFI, D / 2, E); }
        sample_ffn_in_q(lds + RING_OFF, XQS, WQ0, Hb + (size_t)MP * DFF, RA + MP, BSC0, tid, wave, lane);
        if (BOTH(4)) GRID_BAR();
    }
    if (IN(5)) {
        { EpiRes E{XB, nullptr, nullptr, SS2}; run_gemm(lds + RING_OFF, Hb, WFO0, D, DFF, E); }
        if (G == 256) sample_res_ksplit(lds + RING_OFF, MISC + 12, Hb + (size_t)MP * DFF, WFO0, XB + (size_t)MP * D, SS2 + MP, (float*)(WSB + WS_PART), (unsigned*)(ctl + CW_SRES), tid, wave, lane);
        else sample_res(lds + RING_OFF, Hb + (size_t)MP * DFF, DFF, WFO0, XB + (size_t)MP * D, nullptr, nullptr, SS2 + MP, tid, wave, lane);
        if (BOTH(5)) GRID_BAR();
    }
    if (IN(6)) REPEAT(6) {
        { EpiHgrnIn E{QT, KT, VI, GSb, DEC, LB, SS2}; run_gemm(lds + RING_OFF, XB, WHI, NHG, D, E); }
        {
            const int row = tid >> 4, n = tid & 15, fr = lane & 15, fq = lane >> 4; constexpr int NU = NHG / 16;
            SampleA sa; sample_load_a(sa, XB + (size_t)MP * D, wave, lane);
            const float rs = ss_rstd(SS2, MP + row); LAS float* red = (LAS float*)(lds + RING_OFF);
            bf16x8 b[4][4]; int u = bx;
            if (u < NU) { const bf16* bp = WHI + (size_t)u * 16 * D + (size_t)fr * D + fq * 32 + wave * 128;
#pragma unroll
                for (int s2 = 0; s2 < 4; ++s2)
#pragma unroll
                    for (int j2 = 0; j2 < 4; ++j2) b[s2][j2] = *(const bf16x8*)(bp + s2 * 1024 + 8 * j2); }
            for (; u < NU; u += G) {
                f32x4 c0 = (f32x4){0.f, 0.f, 0.f, 0.f}, c1 = c0;
#pragma unroll
                for (int s2 = 0; s2 < 4; ++s2)
#pragma unroll
                    for (int j2 = 0; j2 < 4; ++j2) { c0 = MFMA16(b[s2][j2], sa.a0[s2][j2], c0); c1 = MFMA16(b[s2][j2], sa.a1[s2][j2], c1); }
                const int un = u + G;
                if (un < NU) { const bf16* bp = WHI + (size_t)un * 16 * D + (size_t)fr * D + fq * 32 + wave * 128;
#pragma unroll
                    for (int s2 = 0; s2 < 4; ++s2)
#pragma unroll
                        for (int j2 = 0; j2 < 4; ++j2) b[s2][j2] = *(const bf16x8*)(bp + s2 * 1024 + 8 * j2); }
                *(LAS f32x4*)(red + ((wave * 2 + 0) * 64 + lane) * 4) = c0; *(LAS f32x4*)(red + ((wave * 2 + 1) * 64 + lane) * 4) = c1;
                LDS_BARRIER();
                const int rb = row >> 4, lp = (n >> 2) * 16 + (row & 15), rg = n & 3; float r0 = 0.f;
#pragma unroll
                for (int w = 0; w < 8; ++w) r0 += red[((w * 2 + rb) * 64 + lp) * 4 + rg];
                LDS_BARRIER();
                const int R = u * 16, tile = R >> 8, w2 = R & 255; const int c0i = ((tile & 4) ? 2 * D : 0) + (w2 < 128 ? 0 : D) + (4 * (tile >> 3) + (tile & 3)) * 128 + (w2 & 127);
                SRAW[(size_t)row * NHG + c0i + n] = r0 * rs; }
            __syncthreads();
        }
        if (BOTH(6)) GRID_BAR();
    }
    if (IN(7)) REPEAT(7) {
        const int nseq = NBATCH * 32; const int half = G >= 2 * nseq ? nseq : 0;
        if (bx < nseq || half == 0) { for (int u = bx; u < nseq; u += (half ? nseq : G)) gla_prompt_seq(lds + RING_OFF, QT, KT, VI, GSb, DEC, PIN(I_HNORM), Ob, out + OUT_STP, u >> 5, u & 31, tid, wave, lane); }
        if (bx >= half) { for (int u = bx - half; u < MS * 32; u += G - half) gla_sample_unit(lds + RING_OFF, SRAW, PIN(I_ST), LB, PIN(I_HNORM), Ob, out + OUT_STS, u >> 5, u & 31, tid, wave, lane);
            if (half) { __syncthreads(); convert_items(ptab, S7_LO, S7_HI, (bx - half) * NWAVES + wave, (G - half) * NWAVES, (LAS float*)(lds + RING_OFF + wave * 16384), lane); }
            quant_rows_i8((bx - half) * NWAVES + wave, NFI, (G - half) * NWAVES, lane, [&](int r, const bf16*& sp, signed char*& dp, float*& sc, float& ex) { sp = WFI1 + (size_t)r * D; dp = WQ1 + (size_t)r * D; sc = BSC + r; ex = 1.0f; }); }
        __syncthreads();
        if (BOTH(7)) GRID_BAR();
    }
    if (IN(8)) {
        { EpiRes E{XB, nullptr, nullptr, SS3}; run_gemm(lds + RING_OFF, Ob, WHO, D, D, E); }
        sample_res(lds + RING_OFF, Ob + (size_t)MP * D, D, WHO, XB + (size_t)MP * D, nullptr, nullptr, SS3 + MP, tid, wave, lane);
        if (BOTH(8)) GRID_BAR();
    }
    if (IN(9)) REPEAT(9) {
        quant_rows_i8(vcu * NWAVES + wave, MT, G * NWAVES, lane, [&](int r, const bf16*& sp, signed char*& dp, float*& sc, float& ex) { sp = XB + (size_t)r * D; dp = r < MP ? XQ + (size_t)r * D : XQS + (size_t)(r - MP) * D; sc = RA + r; ex = ss_rstd(SS3, r); });
        GRID_BAR();
        { EpiSwiGLUQ E{Hb, RA, BSC}; run_gemm<EpiSwiGLUQ, true>(lds + RING_OFF, (const bf16*)XQ, (const bf16*)WQ1, NFI, D / 2, E); }
        sample_ffn_in_q(lds + RING_OFF, XQS, WQ1, Hb + (size_t)MP * DFF, RA + MP, BSC, tid, wave, lane);
        if (BOTH(9)) GRID_BAR();
    }
    if (IN(10)) {
        { EpiRes E{XB, nullptr, nullptr, SS4}; run_gemm(lds + RING_OFF, Hb, WFO1, D, DFF, E); }
        if (G == 256) sample_res_ksplit(lds + RING_OFF, MISC + 12, Hb + (size_t)MP * DFF, WFO1, XB + (size_t)MP * D, SS4 + MP, (float*)(WSB + WS_PART), (unsigned*)(ctl + CW_SRES) + 32, tid, wave, lane);
        else sample_res(lds + RING_OFF, Hb + (size_t)MP * DFF, DFF, WFO1, XB + (size_t)MP * D, nullptr, nullptr, SS4 + MP, tid, wave, lane);
        if (BOTH(10)) GRID_BAR();
    }
    if (IN(11)) {
        const float* nf = PIN(I_NFIN); const ssq_t* s3 = SS4;
        for (size_t i = (size_t)vcu * (NWAVES * 64) + tid; i < (size_t)MT * D / 8; i += (size_t)G * NWAVES * 64) { const int row = (int)(i >> 9), c8 = (int)(i & 511);
            const float rs = ss_rstd(s3, row); const v4u x = ((const v4u*)XB)[i]; const f32x4 w0 = ((const f32x4*)nf)[2 * c8], w1 = ((const f32x4*)nf)[2 * c8 + 1];
            f32x4 y0, y1; y0[0] = __builtin_bit_cast(float, x.x << 16); y0[1] = __builtin_bit_cast(float, x.x & 0xffff0000u); y0[2] = __builtin_bit_cast(float, x.y << 16); y0[3] = __builtin_bit_cast(float, x.y & 0xffff0000u);
            y1[0] = __builtin_bit_cast(float, x.z << 16); y1[1] = __builtin_bit_cast(float, x.z & 0xffff0000u); y1[2] = __builtin_bit_cast(float, x.w << 16); y1[3] = __builtin_bit_cast(float, x.w & 0xffff0000u);
            ((f32x4*)(out + OUT_Y))[2 * i] = y0 * rs * w0; ((f32x4*)(out + OUT_Y))[2 * i + 1] = y1 * rs * w1; }
    }
#undef IN
#undef BOTH
#undef GRID_BAR
#undef out
#undef WSB
#undef XQ
#undef XQS
#undef RA
#undef WQ1
#undef BSC
#undef WQ0
#undef WQO
#undef WQQ
#undef BSCQ
#undef BSCO
#undef BSC0
#undef WQKV
#undef WO
#undef WFI0
#undef WFO0
#undef WHI
#undef WHO
#undef WFI1
#undef WFO1
#undef XB
#undef Qb
#undef Kb
#undef Vb
#undef Ob
#undef Hb
#undef QT
#undef KT
#undef KP
#undef VI
#undef GSb
#undef DEC
#undef SRAW
#undef LB
#undef SSB
#undef SS0
#undef SS1
#undef SS2
#undef SS3
#undef SS4
}

extern "C" void kernel_launch(void* const* d_in, const int* in_sizes, int n_in, void* d_out, int out_size, void* d_ws, size_t ws_size, hipStream_t stream) {
    static int grid = 0;
    if (grid == 0) {
        if (n_in != 19 || (size_t)out_size != OUT_END || ws_size < WS_END) { fprintf(stderr, "kernel_launch: unexpected shapes (n_in %d, out %d, ws %zu); nothing launched\n", n_in, out_size, ws_size); grid = -1; return; }
        int dev = 0, cus = 0, per_cu = 0;
        if (hipGetDevice(&dev) != hipSuccess || hipDeviceGetAttribute(&cus, hipDeviceAttributeMultiprocessorCount, dev) != hipSuccess) { grid = -1; return; }
        if (hipFuncSetAttribute((const void*)fwd_kernel, hipFuncAttributeMaxDynamicSharedMemorySize, LDS_BYTES) != hipSuccess) { fprintf(stderr, "kernel_launch: hipFuncSetAttribute failed\n"); grid = -1; return; }
        if (hipOccupancyMaxActiveBlocksPerMultiprocessor(&per_cu, (const void*)fwd_kernel, NWAVES * 64, LDS_BYTES) != hipSuccess || per_cu < 1) { fprintf(stderr, "kernel_launch: occupancy query says %d blocks per CU\n", per_cu); }
        (void)hipGetLastError();
        grid = cus;
    }
    if (grid < 0) return;
    if (hipMemsetAsync((char*)d_ws + WS_CTL, 0, CTL_ZERO_BYTES, stream) != hipSuccess) { fprintf(stderr, "kernel_launch: memset failed\n"); return; }
    Args a{};
    for (int i = 0; i < 19; ++i) a.in[i] = (const float*)d_in[i];
    a.out = (float*)d_out; a.ws = (unsigned char*)d_ws;
    for (int li = 0; li < N_LAUNCHES; ++li) {
        a.ph_lo = (N_LAUNCHES == 1) ? 0 : li; a.ph_hi = (N_LAUNCHES == 1) ? NPHASE : li + 1; a.li = li; a.pad = 0;
        hipLaunchKernelGGL(fwd_kernel, dim3(grid), dim3(NWAVES * 64), LDS_BYTES, stream, a);
        const hipError_t le = hipPeekAtLastError();
        if (le != hipSuccess) { fprintf(stderr, "kernel_launch: launch %d failed: %s\n", li, hipGetErrorName(le)); break; }
    }
#ifdef EXTRA_PHASES
    { const int extra[] = {EXTRA_PHASES}; for (int e : extra) { a.ph_lo = e; a.ph_hi = e + 1; a.li = 1; hipLaunchKernelGGL(fwd_kernel, dim3(grid), dim3(NWAVES * 64), LDS_BYTES, stream, a); } }
#endif
#ifdef EXTRA_PHASES
    { const int extra[] = {EXTRA_PHASES}; for (int e : extra) { a.ph_lo = e; a.ph_hi = e + 1; a.li = 1; hipLaunchKernelGGL(fwd_kernel, dim3(grid), dim3(NWAVES * 64), LDS_BYTES, stream, a); } }
#endif
}
```

```cpp
#include <hip/hip_runtime.h>
#include <cstdio>
#include <cstdint>
namespace pg8 {
#define PG8_LAS __attribute__((address_space(3)))
typedef unsigned short bf16_t;
typedef short bf16x8 __attribute__((ext_vector_type(8)));
typedef float f32x4 __attribute__((ext_vector_type(4)));
typedef unsigned u32x4 __attribute__((ext_vector_type(4)));
constexpr int BM = 256, BK = 64, HALF = 128, HTB = HALF * BK * 2  , STAGE_BYTES = 8 * HTB, NXCD = 8, WGM = 8;

__host__ __device__ __forceinline__ int lds_byte(int r, int c) { const int st = (r >> 4) * 2 + (c >> 5), rr = r & 15, cc = c & 31, ob = rr * 64 + cc * 2; return st * 1024 + (ob ^ (((ob >> 9) & 1) << 5)); }
__host__ __device__ __forceinline__ void stage_rc(int b, int& R, int& C) { const int st = b / 1024, sb = b % 1024, swz = sb ^ (((sb >> 9) & 1) << 5); R = (st >> 1) * 16 + swz / 64; C = (st & 1) * 32 + (swz % 64) / 2; }
__host__ __device__ __forceinline__ int perm32(int rho) { const int n = rho >> 4, i = rho & 15; return 8 * (i >> 2) + 4 * n + (i & 3); }

struct Unit { int pm, pn; };
struct Gemm { const bf16_t* A; const bf16_t* Bt; int M, N, K; };

struct StaticOrder {
    int nM, nN, nwg, G, c, nx;
    __host__ __device__ void init(int M, int N, int G_, int c_, int nx_ = NXCD) { nM = M / BM; nN = N / BM; nwg = nM * nN; G = G_; c = c_; nx = nx_; }
    __host__ __device__ bool next(int i, Unit& u) const {
        const long L = (long)i * G + c; if (L >= nwg) return false;
        int wgid = (int)L; { const int q = nwg / nx, r = nwg % nx, xcd = wgid % nx, off = wgid / nx; wgid = (xcd < r ? xcd * (q + 1) : r * (q + 1) + (xcd - r) * q) + off; }
        const int nig = WGM * nN, gid = wgid / nig, fm = gid * WGM, gsz = (nM - fm) < WGM ? (nM - fm) : WGM;
        u.pm = fm + ((wgid % nig) % gsz); u.pn = (wgid % nig) / gsz; return true;
    }
    __device__ __forceinline__ void a_ready(const Unit&) const {}
    __device__ __forceinline__ void done(const Unit&) const {}
};
__device__ __forceinline__ unsigned cvt_pk_bf16(float lo, float hi) { unsigned r; asm volatile("v_cvt_pk_bf16_f32 %0, %1, %2" : "=v"(r) : "v"(lo), "v"(hi)); return r; }
typedef int i32x4 __attribute__((ext_vector_type(4)));
template <bool I8> __device__ __forceinline__ f32x4 mma16(bf16x8 b, bf16x8 a, f32x4 c) {
    if constexpr (I8) return __builtin_bit_cast(f32x4, __builtin_amdgcn_mfma_i32_16x16x64_i8(__builtin_bit_cast(i32x4, b), __builtin_bit_cast(i32x4, a), __builtin_bit_cast(i32x4, c), 0, 0, 0));
    else return __builtin_amdgcn_mfma_f32_16x16x32_bf16(b, a, c, 0, 0, 0);
}
template <class Epi, class Sched, bool ALIGN_EPI = false, bool SP2 = false, bool I8 = false>
__device__ __forceinline__ void gemm_phase(PG8_LAS unsigned char* lds, const Gemm g, const Sched& S, const Epi& E) {
    const int tid = threadIdx.x, wid = __builtin_amdgcn_readfirstlane(tid >> 6), lane = tid & 63, wr = wid >> 2, wc = wid & 3, fr = lane & 15, fq = lane >> 4;
    const int K = g.K, nt = K / BK;
    unsigned voffA[2], voffB[2];
#pragma unroll
    for (int i = 0; i < 2; ++i) { int R, C; stage_rc(tid * 16 + i * 8192, R, C); const int Rb = Epi::PERM ? ((R & ~31) + perm32(R & 31)) : R;
        voffA[i] = (unsigned)(R * K + C) * 2u; voffB[i] = (unsigned)(Rb * K + C) * 2u; }
    const size_t kstep = (size_t)(BK * 2);
    const size_t hstep = (size_t)HALF * K * 2;
    const size_t tstep = 2 * hstep;
    const unsigned ldsw = (unsigned)wid * 1024u;
    const int aoff = lds_byte(wr * 64 + fr, fq * 8), boff = lds_byte(wc * 32 + fr, fq * 8);
#define PG8_SA(b, h) (((b) * 2 + (h)) * HTB)
#define PG8_SB(b, h) ((4 + (b) * 2 + (h)) * HTB)
#define PG8_STAGE(bufoff, gbase, voff) do { _Pragma("unroll") for (int _i = 0; _i < 2; ++_i) \
        __builtin_amdgcn_global_load_lds((const unsigned*)((const char*)(gbase) + (voff)[_i]), (PG8_LAS unsigned*)(lds + (bufoff) + ldsw + _i * 8192), 16, 0, 0); } while (0)
#define PG8_LDA(dst, b, h) do { _Pragma("unroll") for (int m = 0; m < 4; ++m) _Pragma("unroll") for (int k = 0; k < 2; ++k) dst[m][k] = *(const PG8_LAS bf16x8*)(lds + PG8_SA(b, h) + aoff + m * 2048 + k * 1024); } while (0)
#define PG8_LDB(dst, b, h) do { _Pragma("unroll") for (int n = 0; n < 2; ++n) _Pragma("unroll") for (int k = 0; k < 2; ++k) dst[n][k] = *(const PG8_LAS bf16x8*)(lds + PG8_SB(b, h) + boff + n * 2048 + k * 1024); } while (0)
#define PG8_MMA(ai, bj, At, Bt) do { __builtin_amdgcn_s_setprio(1); _Pragma("unroll") for (int m = 0; m < 4; ++m) _Pragma("unroll") for (int n = 0; n < 2; ++n) _Pragma("unroll") for (int k = 0; k < 2; ++k) \
        acc[ai][bj][m][n] = mma16<I8>(Bt[n][k], At[m][k], acc[ai][bj][m][n]); __builtin_amdgcn_s_setprio(0); } while (0)
#define PG8_WAIT_V(n) asm volatile("s_waitcnt vmcnt(" #n ")" ::: "memory")
#define PG8_WAIT_L(n) asm volatile("s_waitcnt lgkmcnt(" #n ")" ::: "memory")
#define PG8_BAR __builtin_amdgcn_s_barrier()
#define PG8_SCHED __builtin_amdgcn_sched_barrier(0)
    Unit cur, nxt; int ui = 0;
    if (!S.next(0, cur)) return;
    f32x4 acc[2][2][4][2];
#pragma unroll
    for (int a = 0; a < 2; ++a)
#pragma unroll
        for (int b = 0; b < 2; ++b)
#pragma unroll
            for (int m = 0; m < 4; ++m)
#pragma unroll
                for (int n = 0; n < 2; ++n) acc[a][b][m][n] = (f32x4){0.f, 0.f, 0.f, 0.f};
    bf16x8 At[4][2], B0[2][2], B1[2][2];
    const char* cA = (const char*)g.A + (size_t)cur.pm * tstep; const char* cB = (const char*)g.Bt + (size_t)cur.pn * tstep;
    S.a_ready(cur);
    if constexpr (SP2) {
        PG8_STAGE(PG8_SB(0, 0), cB, voffB); PG8_STAGE(PG8_SB(0, 1), cB + hstep, voffB); PG8_STAGE(PG8_SA(0, 0), cA, voffA); PG8_STAGE(PG8_SA(0, 1), cA + hstep, voffA);
        if (wr == 1) PG8_BAR;
        PG8_WAIT_V(2); PG8_BAR;
        PG8_STAGE(PG8_SB(1, 0), cB + kstep, voffB); PG8_STAGE(PG8_SA(1, 0), cA + kstep, voffA); PG8_STAGE(PG8_SB(1, 1), cB + hstep + kstep, voffB);
        PG8_WAIT_V(6); PG8_BAR;
    } else {
        PG8_STAGE(PG8_SB(0, 0), cB, voffB); PG8_STAGE(PG8_SA(0, 0), cA, voffA); PG8_STAGE(PG8_SB(0, 1), cB + hstep, voffB); PG8_STAGE(PG8_SA(0, 1), cA + hstep, voffA);
        if (wr == 1) PG8_BAR;
        PG8_WAIT_V(4); PG8_BAR;
        PG8_STAGE(PG8_SB(1, 0), cB + kstep, voffB); PG8_STAGE(PG8_SA(1, 0), cA + kstep, voffA); PG8_STAGE(PG8_SB(1, 1), cB + hstep + kstep, voffB);
        PG8_WAIT_V(6); PG8_BAR;
    }
    for (;;) {
        const bool has_next = S.next(ui + 1, nxt);
        const char* nA = has_next ? (const char*)g.A + (size_t)nxt.pm * tstep : cA; const char* nB = has_next ? (const char*)g.Bt + (size_t)nxt.pn * tstep : cB;
        for (int t = 0; t < nt; t += 2) {
            const bool last = (t == nt - 2);
            const char* a1 = cA + (size_t)(t + 1) * kstep;
            const char* a2 = last ? nA : cA + (size_t)(t + 2) * kstep; const char* b2 = last ? nB : cB + (size_t)(t + 2) * kstep;
            const char* a3 = a2 + kstep; const char* b3 = b2 + kstep;
            if (last && has_next) S.a_ready(nxt);
            if constexpr (SP2) {
            PG8_LDB(B0, 0, 0); PG8_LDB(B1, 0, 1); PG8_SCHED; PG8_LDA(At, 0, 0); PG8_STAGE(PG8_SA(1, 1), a1 + hstep, voffA);
            PG8_WAIT_V(8); PG8_WAIT_L(0); PG8_BAR; PG8_MMA(0, 0, At, B0); PG8_MMA(0, 1, At, B1); PG8_BAR; PG8_SCHED;
            PG8_LDA(At, 0, 1); PG8_STAGE(PG8_SB(0, 0), b2, voffB); PG8_STAGE(PG8_SB(0, 1), b2 + hstep, voffB); PG8_STAGE(PG8_SA(0, 0), a2, voffA);
            PG8_WAIT_V(8); PG8_WAIT_L(0); PG8_BAR; PG8_MMA(1, 0, At, B0); PG8_MMA(1, 1, At, B1); PG8_BAR; PG8_SCHED;
            PG8_LDB(B0, 1, 0); PG8_LDB(B1, 1, 1); PG8_SCHED; PG8_LDA(At, 1, 0); PG8_STAGE(PG8_SA(0, 1), a2 + hstep, voffA);
            PG8_WAIT_V(8); PG8_WAIT_L(0); PG8_BAR; PG8_MMA(0, 0, At, B0); PG8_MMA(0, 1, At, B1); PG8_BAR; PG8_SCHED;
            PG8_LDA(At, 1, 1); PG8_STAGE(PG8_SB(1, 0), b3, voffB); PG8_STAGE(PG8_SB(1, 1), b3 + hstep, voffB); PG8_STAGE(PG8_SA(1, 0), a3, voffA);
            PG8_WAIT_V(8); PG8_WAIT_L(0); PG8_BAR; PG8_MMA(1, 0, At, B0); PG8_MMA(1, 1, At, B1); PG8_BAR; PG8_SCHED;
            } else {
            PG8_LDB(B0, 0, 0); PG8_SCHED; PG8_LDA(At, 0, 0); PG8_STAGE(PG8_SA(1, 1), a1 + hstep, voffA);
            PG8_WAIT_L(8); PG8_BAR; PG8_WAIT_L(0); PG8_MMA(0, 0, At, B0); PG8_BAR; PG8_SCHED;
            PG8_LDB(B1, 0, 1); PG8_STAGE(PG8_SB(0, 0), b2, voffB);
            PG8_BAR; PG8_WAIT_L(0); PG8_MMA(0, 1, At, B1); PG8_BAR;
            PG8_LDA(At, 0, 1); PG8_STAGE(PG8_SA(0, 0), a2, voffA);
            PG8_BAR; PG8_WAIT_L(0); PG8_MMA(1, 0, At, B0); PG8_BAR; PG8_SCHED;
            PG8_STAGE(PG8_SB(0, 1), b2 + hstep, voffB);
            PG8_WAIT_V(6); PG8_BAR; PG8_MMA(1, 1, At, B1); PG8_BAR;
            PG8_LDB(B0, 1, 0); PG8_SCHED; PG8_LDA(At, 1, 0); PG8_STAGE(PG8_SA(0, 1), a2 + hstep, voffA);
            PG8_WAIT_L(8); PG8_BAR; PG8_WAIT_L(0); PG8_MMA(0, 0, At, B0); PG8_BAR; PG8_SCHED;
            PG8_LDB(B1, 1, 1); PG8_STAGE(PG8_SB(1, 0), b3, voffB);
            PG8_BAR; PG8_WAIT_L(0); PG8_MMA(0, 1, At, B1); PG8_BAR;
            PG8_LDA(At, 1, 1); PG8_STAGE(PG8_SA(1, 0), a3, voffA);
            PG8_BAR; PG8_WAIT_L(0); PG8_MMA(1, 0, At, B0); PG8_BAR; PG8_SCHED;
            PG8_STAGE(PG8_SB(1, 1), b3 + hstep, voffB);
            PG8_WAIT_V(6); PG8_BAR; PG8_MMA(1, 1, At, B1); PG8_BAR;
            }
        }
        if constexpr (ALIGN_EPI) { if (wr == 0) PG8_BAR; }
        if constexpr (!Epi::AFTER_DRAIN) { E(acc, cur, wr, wc, fr, fq); S.done(cur); }
        if (!has_next) break;
#pragma unroll
        for (int a = 0; a < 2; ++a)
#pragma unroll
            for (int b = 0; b < 2; ++b)
#pragma unroll
                for (int m = 0; m < 4; ++m)
#pragma unroll
                    for (int n = 0; n < 2; ++n) acc[a][b][m][n] = (f32x4){0.f, 0.f, 0.f, 0.f};
        cur = nxt; cA = nA; cB = nB; ++ui;
        if constexpr (ALIGN_EPI) { if (wr == 1) PG8_BAR; }
    }
    PG8_WAIT_V(0);
    if constexpr (!ALIGN_EPI) { if (wr == 0) PG8_BAR; }
    PG8_BAR;
    if constexpr (Epi::AFTER_DRAIN) { E.fused(acc, cur, wr, wc, fr, fq, lds, wid, lane); S.done(cur); }
#undef PG8_SA
#undef PG8_SB
#undef PG8_STAGE
#undef PG8_LDA
#undef PG8_LDB
#undef PG8_MMA
#undef PG8_WAIT_V
#undef PG8_WAIT_L
#undef PG8_BAR
#undef PG8_SCHED
}
}

#ifndef MK_N_LAUNCHES
#define MK_N_LAUNCHES 1
#endif
constexpr int NPHASE = 12;
constexpr int N_LAUNCHES = MK_N_LAUNCHES;
constexpr int NWAVES = 8;

constexpr int D = 4096, MP = 8192, MS = 32, MT = MP + MS, SEQ = 2048, NBATCH = 4, QKVN = 5120, KVD = 512, DFF = 11008, NFI = 2 * DFF, NHG = 4 * D;
constexpr float RMS_EPS = 1e-5f;
constexpr float LOG2E = 1.4426950408889634f;
constexpr size_t OUT_Y = 0, OUT_WKP = (size_t)MT * D, OUT_WVP = OUT_WKP + 262144, OUT_STP = OUT_WVP + 262144, OUT_WKS = OUT_STP + 2097152, OUT_WVS = OUT_WKS + 2097152, OUT_STS = OUT_WVS + 2097152, OUT_END = OUT_STS + 16777216;

constexpr size_t MiB = 1u << 20;
constexpr size_t WS_CTL = 0, CTL_ZERO_BYTES = 1 * MiB;
constexpr size_t WS_LB = 1 * MiB;
constexpr size_t WS_WQKV = 2 * MiB, WS_WO = 42 * MiB, WS_WFI0 = 74 * MiB, WS_WFO0 = 246 * MiB, WS_WHI = 332 * MiB, WS_WHO = 460 * MiB, WS_WFI1 = 492 * MiB, WS_WFO1 = 664 * MiB;
constexpr size_t WS_XN = 750 * MiB, WS_X = 815 * MiB, WS_Q = 944 * MiB, WS_K = 1009 * MiB, WS_V = 1018 * MiB, WS_O = 1027 * MiB, WS_H = 1092 * MiB;
constexpr size_t WS_QT = 1265 * MiB, WS_KT = 1330 * MiB, WS_KP = 1395 * MiB, WS_VI = 1460 * MiB, WS_GS = 1525 * MiB, WS_DEC = 1590 * MiB, WS_SRAW = 1592 * MiB, WS_END = 1594 * MiB;
constexpr size_t WS_XQ = 815 * MiB, WS_RA = 847 * MiB, WS_WQ1 = 848 * MiB, WS_BSC = 935 * MiB;
constexpr size_t WS_WQ0 = 1265 * MiB, WS_BSC0 = 1395 * MiB, WS_WQO = 1396 * MiB, WS_BSCO = 1412 * MiB, WS_WQQ = 1413 * MiB, WS_BSCQ = 1433 * MiB;
static_assert(WS_RA - WS_XQ >= (size_t)MP * D && WS_BSC - WS_WQ1 >= (size_t)NFI * D && WS_Q - WS_BSC >= (size_t)NFI * 4, "ws map (int8)");
static_assert(WS_WO - WS_WQKV >= (size_t)QKVN * D * 2 && WS_WFO0 - WS_WFI0 >= (size_t)NFI * D * 2 && WS_WHI - WS_WFO0 >= (size_t)D * DFF * 2 && WS_WHO - WS_WHI >= (size_t)NHG * D * 2, "ws map (weights)");
static_assert(WS_X - WS_XN >= (size_t)MT * D * 2 && WS_Q - WS_X >= (size_t)MT * D * 4 && WS_K - WS_Q >= (size_t)MT * D * 2 && WS_V - WS_K >= (size_t)MT * KVD * 2 && WS_QT - WS_H >= (size_t)MT * DFF * 2, "ws map (activations)");
constexpr int CW_TMO = 0, CW_CODE = 1, CW_BAR = 4096, CW_SS = 16384, SS_STRIDE = 8448;
static_assert(CW_SS * 4 + 5 * SS_STRIDE * 8 <= (int)CTL_ZERO_BYTES, "CTL words inside the memset region");
constexpr int CW_SRES = 8384;
constexpr size_t WS_PART = 936 * MiB;
constexpr int CW_SIDE_A = 8192, CW_SIDE_B = 8256, CW_FLAG_WO = 8320;

constexpr int RING_OFF = 0, RING_BYTES = 131072;
constexpr int LDSCTL_OFF = RING_BYTES, MISC_OFF = LDSCTL_OFF + 320;
constexpr int LDS_BYTES = 147456;
constexpr int PTAB_OFF = LDSCTL_OFF + 1024;

#define GAS __attribute__((address_space(1)))
#define LAS __attribute__((address_space(3)))
typedef unsigned short bf16;
typedef unsigned v4u __attribute__((ext_vector_type(4)));
typedef unsigned v2u __attribute__((ext_vector_type(2)));
typedef float f32x4 __attribute__((ext_vector_type(4)));
typedef float f32x16 __attribute__((ext_vector_type(16)));
typedef short bf16x8 __attribute__((ext_vector_type(8)));
typedef short s16x4 __attribute__((ext_vector_type(4)));
typedef GAS unsigned gu32;
#define RLX_AGENT __ATOMIC_RELAXED, __HIP_MEMORY_SCOPE_AGENT
#define LDS_WAIT() asm volatile("s_waitcnt lgkmcnt(0)" ::: "memory")
#define VM_WAIT() asm volatile("s_waitcnt vmcnt(0)" ::: "memory")
#define MFMA32(a, b, c) __builtin_amdgcn_mfma_f32_32x32x16_bf16((a), (b), (c), 0, 0, 0)
#define MFMA16(a, b, c) __builtin_amdgcn_mfma_f32_16x16x32_bf16((a), (b), (c), 0, 0, 0)
typedef __bf16 bf16x2_t __attribute__((ext_vector_type(2)));
typedef float f32x2_t __attribute__((ext_vector_type(2)));
__device__ __forceinline__ unsigned pk2(float lo, float hi) { f32x2_t v = {lo, hi}; bf16x2_t b = __builtin_convertvector(v, bf16x2_t); return __builtin_bit_cast(unsigned, b); }
__device__ __forceinline__ float bf2f(bf16 b) { return __builtin_bit_cast(float, (unsigned)b << 16); }
__device__ __forceinline__ float fast_exp2(float x) { return __builtin_amdgcn_exp2f(x); }
__device__ __forceinline__ float fast_rcp(float x) { return __builtin_amdgcn_rcpf(x); }
__device__ __forceinline__ float sigmoidf_(float x) { return fast_rcp(1.0f + fast_exp2(-x * LOG2E)); }
__device__ __forceinline__ float siluf_(float x) { return x * sigmoidf_(x); }
__device__ __forceinline__ int crow(int reg, int h) { return (reg & 3) + 8 * (reg >> 2) + 4 * h; }
typedef short v4i16_t __attribute__((ext_vector_type(4)));
__device__ __forceinline__ s16x4 tr_read(const LAS unsigned char* p) { return __builtin_bit_cast(s16x4, __builtin_amdgcn_ds_read_tr16_b64_v4i16((LAS v4i16_t*)p)); }
__device__ __forceinline__ bf16x8 tr_frag(const LAS unsigned char* p_lo, const LAS unsigned char* p_hi) { const s16x4 lo = tr_read(p_lo), hi = tr_read(p_hi); return __builtin_shufflevector(lo, hi, 0, 1, 2, 3, 4, 5, 6, 7); }
typedef unsigned long long ssq_t;
__device__ __forceinline__ ssq_t ss_fix(float sq) { return (ssq_t)(sq * 16777216.0f + 0.5f); }
__device__ __forceinline__ float ss_rstd(const ssq_t* ss, int r) { return __builtin_amdgcn_rsqf((float)ss[r] * (1.0f / (16777216.0f * D)) + RMS_EPS); }
__device__ __forceinline__ float wave_sum(float v) {
#pragma unroll
    for (int o = 1; o < 64; o <<= 1) v += __shfl_xor(v, o);
    return v;
}
__device__ __forceinline__ float wave_max(float v) {
#pragma unroll
    for (int o = 1; o < 64; o <<= 1) v = fmaxf(v, __shfl_xor(v, o));
    return v;
}
#define XB_TMO      128
#define XB_XCNT(j)  (256  + 64 * (j))
#define XB_XSUB(j)  (1280 + 64 * (j))
#define XB_XGEN(j)  (2304 + 64 * (j))
#define XB_TOP      3328
#define XB_TOPGEN   3392
#define XCD_BAR_WORDS 3456
#define XB_SPIN_CAP (1u << 18)

__device__ __forceinline__ unsigned xb_ld(unsigned* p)              { return __hip_atomic_load(p, __ATOMIC_RELAXED, __HIP_MEMORY_SCOPE_AGENT); }
__device__ __forceinline__ unsigned xb_add(unsigned* p, unsigned v) { return __hip_atomic_fetch_add(p, v, __ATOMIC_RELAXED, __HIP_MEMORY_SCOPE_AGENT); }
__device__ __forceinline__ unsigned xb_xcc_id() { return (unsigned)__builtin_amdgcn_s_getreg((3 << 11) | 20) & 0xFu; }
#define XB_SPIN(cond, bar) do { unsigned _sp = 0; while (cond) { __builtin_amdgcn_s_sleep(1); \
    if ((++_sp & 255u) == 0u) { if (xb_ld(&(bar)[XB_TMO])) break; if (_sp > XB_SPIN_CAP) { atomicAdd(&(bar)[XB_TMO], 1u); break; } } } } while (0)

struct XcdBarrier {
    unsigned* bar; unsigned x;
    volatile LAS unsigned* st;
};

__device__ __forceinline__ XcdBarrier xcd_barrier_post(unsigned* bar, volatile LAS unsigned* st) {
    XcdBarrier b; b.bar = bar; b.x = xb_xcc_id(); b.st = st;
    if (threadIdx.x == 0) (void)xb_add(&bar[XB_XCNT(b.x)], 1u);
    return b;
}
__device__ __forceinline__ void xcd_barrier_complete(unsigned* bar, unsigned x, unsigned& nloc, unsigned& nx) {
    const unsigned G = gridDim.x * gridDim.y * gridDim.z;
    unsigned sum, cnt, mine, sp = 0u;
    for (;;) {
        sum = 0u; cnt = 0u; mine = 0u;
#pragma unroll
        for (unsigned j = 0; j < 16; ++j) { const unsigned c = xb_ld(&bar[XB_XCNT(j)]); sum += c; cnt += (c > 0u) ? 1u : 0u; mine = (j == x) ? c : mine; }
        if (sum == G) break;
        __builtin_amdgcn_s_sleep(1);
        if ((++sp & 255u) == 0u) { if (xb_ld(&bar[XB_TMO])) break; if (sp > XB_SPIN_CAP) { atomicAdd(&bar[XB_TMO], 1u); break; } }
    }
    nloc = mine > 0u ? mine : 1u; nx = cnt > 0u ? cnt : 1u;
}

__device__ __forceinline__ void xcd_barrier(const XcdBarrier& b) {
    asm volatile("s_waitcnt vmcnt(0)" ::: "memory");
    __syncthreads();
    if (threadIdx.x == 0) {
        unsigned* bar = b.bar;
        __builtin_amdgcn_s_waitcnt(0);
        unsigned nloc = b.st[0], nx = b.st[1];
        if (nloc == 0u) { xcd_barrier_complete(bar, b.x, nloc, nx); b.st[0] = nloc; b.st[1] = nx; }
        const unsigned old = xb_add(&bar[XB_XSUB(b.x)], 1u);
        const unsigned gen = old / nloc;
        if (old + 1u == (gen + 1u) * nloc) {
            __builtin_amdgcn_fence(__ATOMIC_RELEASE, "agent");
            asm volatile("s_waitcnt vmcnt(0)" ::: "memory");
            const unsigned og = xb_add(&bar[XB_TOP], 1u);
            const unsigned tg = og / nx;
            if (og + 1u == (tg + 1u) * nx) xb_add(&bar[XB_TOPGEN], 1u);
            else XB_SPIN(xb_ld(&bar[XB_TOPGEN]) == tg, bar);
            __builtin_amdgcn_fence(__ATOMIC_ACQUIRE, "agent");
            xb_add(&bar[XB_XGEN(b.x)], 1u);
            asm volatile("s_waitcnt vmcnt(0)" ::: "memory");
        } else {
            XB_SPIN(xb_ld(&bar[XB_XGEN(b.x)]) == gen, bar);
            __builtin_amdgcn_fence(__ATOMIC_ACQUIRE, "agent");
            asm volatile("s_waitcnt vmcnt(0)" ::: "memory");
        }
    }
    __syncthreads();
}

__device__ __forceinline__ void side_barrier(unsigned* ctr, unsigned target, unsigned* tmo) {
    asm volatile("s_waitcnt vmcnt(0)" ::: "memory");
    __syncthreads();
    if (threadIdx.x == 0) {
        __builtin_amdgcn_fence(__ATOMIC_RELEASE, "agent");
        asm volatile("s_waitcnt vmcnt(0)" ::: "memory");
        (void)xb_add(ctr, 1u);
        XB_SPIN(xb_ld(ctr) < target, tmo - XB_TMO);
        __builtin_amdgcn_fence(__ATOMIC_ACQUIRE, "agent");
        asm volatile("s_waitcnt vmcnt(0)" ::: "memory");
    }
    __syncthreads();
}

typedef pg8::Unit Unit;
template <bool Q8> struct EpiQKVT {
    static constexpr bool PERM = true, AFTER_DRAIN = false;
    bf16 *Q, *K, *V; const float* bias; float *wk, *wv; const ssq_t* ss; const float* ra; const float* bs; int pn0;
    __device__ __forceinline__ void operator()(const f32x4 (&acc)[2][2][4][2], const Unit& u, int wr, int wc, int fr, int fq) const {
        const int pn = u.pn + pn0; const int row0 = u.pm * 256 + wr * 64 + fr, colt = pn * 256;
        bf16* base; int ldc, cc; float* win = nullptr;
        if (pn < 16) { base = Q; ldc = D; cc = colt; } else if (pn < 18) { base = K; ldc = KVD; cc = colt - D; win = wk; } else { base = V; ldc = KVD; cc = colt - D - KVD; win = wv; }
        const int col0 = cc + wc * 32 + 8 * fq, bcol0 = colt + wc * 32 + 8 * fq;
        f32x4 bv[2][2];
#pragma unroll
        for (int bj = 0; bj < 2; ++bj)
#pragma unroll
            for (int n = 0; n < 2; ++n) bv[bj][n] = *(const f32x4*)(bias + bcol0 + bj * 128 + 4 * n);
        const bool dowin = (win != nullptr) && ((u.pm & 7) == 7);
        float rsv[2][4];
#pragma unroll
        for (int ai = 0; ai < 2; ++ai)
#pragma unroll
            for (int m = 0; m < 4; ++m) rsv[ai][m] = Q8 ? ra[row0 + ai * 128 + m * 16] : ss_rstd(ss, row0 + ai * 128 + m * 16);
        f32x4 bsv[2][2];
        if constexpr (Q8) {
#pragma unroll
            for (int bj = 0; bj < 2; ++bj)
#pragma unroll
                for (int n = 0; n < 2; ++n) bsv[bj][n] = *(const f32x4*)(bs + bcol0 + bj * 128 + 4 * n);
        }
#pragma unroll
        for (int ai = 0; ai < 2; ++ai)
#pragma unroll
            for (int m = 0; m < 4; ++m) { const int r = row0 + ai * 128 + m * 16; bf16* rowp = base + (size_t)r * ldc + col0; const float rs = rsv[ai][m];
#pragma unroll
                for (int bj = 0; bj < 2; ++bj) { f32x4 v0, v1;
                    if constexpr (Q8) { const pg8::i32x4 i0 = __builtin_bit_cast(pg8::i32x4, acc[ai][bj][m][0]), i1 = __builtin_bit_cast(pg8::i32x4, acc[ai][bj][m][1]);
#pragma unroll
                        for (int j = 0; j < 4; ++j) { v0[j] = (float)i0[j] * (rs * bsv[bj][0][j]) + bv[bj][0][j]; v1[j] = (float)i1[j] * (rs * bsv[bj][1][j]) + bv[bj][1][j]; } }
                    else { v0 = acc[ai][bj][m][0] * rs + bv[bj][0]; v1 = acc[ai][bj][m][1] * rs + bv[bj][1]; }
                    v4u w; w.x = pk2(v0[0], v0[1]); w.y = pk2(v0[2], v0[3]); w.z = pk2(v1[0], v1[1]); w.w = pk2(v1[2], v1[3]);
                    *(v4u*)(rowp + bj * 128) = w;
                    if (ai == 1 && dowin) { float* wp = win + ((size_t)((u.pm >> 3) * 128 + wr * 64 + m * 16 + fr) * KVD + col0 + bj * 128); *(f32x4*)wp = v0; *(f32x4*)(wp + 4) = v1; } } }
    }
};
typedef EpiQKVT<false> EpiQKV;
template <bool Q8> struct EpiResT {
    static constexpr bool PERM = true, AFTER_DRAIN = false;
    bf16* xb; float* out; const float* bias; ssq_t* ss; const float* ra; const float* bs;
    __device__ __forceinline__ void operator()(const f32x4 (&acc)[2][2][4][2], const Unit& u, int wr, int wc, int fr, int fq) const {
        const int row0 = u.pm * 256 + wr * 64 + fr, col0 = u.pn * 256 + wc * 32 + 8 * fq;
        f32x4 bv[2][2], bsv[2][2]; float rsv[2][4];
        if constexpr (Q8) {
#pragma unroll
            for (int bj = 0; bj < 2; ++bj)
#pragma unroll
                for (int n = 0; n < 2; ++n) bsv[bj][n] = *(const f32x4*)(bs + col0 + bj * 128 + 4 * n);
#pragma unroll
            for (int ai = 0; ai < 2; ++ai)
#pragma unroll
                for (int m = 0; m < 4; ++m) rsv[ai][m] = ra[row0 + ai * 128 + m * 16];
        }
#pragma unroll
        for (int bj = 0; bj < 2; ++bj)
#pragma unroll
            for (int n = 0; n < 2; ++n) bv[bj][n] = bias ? *(const f32x4*)(bias + col0 + bj * 128 + 4 * n) : (f32x4){0.f, 0.f, 0.f, 0.f};
#pragma unroll
        for (int ai = 0; ai < 2; ++ai) {
          v4u xra[2][4][2];
          if (!Q8 || true) {
#pragma unroll
            for (int m = 0; m < 4; ++m)
#pragma unroll
                for (int bj = 0; bj < 2; ++bj) xra[ai][m][bj] = *(const v4u*)(xb + (unsigned)(row0 + ai * 128 + m * 16) * D + col0 + bj * 128);
          }
#pragma unroll
            for (int m = 0; m < 4; ++m) { const int r = row0 + ai * 128 + m * 16; const unsigned off = (unsigned)r * D + col0; float sq = 0.f;
#pragma unroll
                for (int bj = 0; bj < 2; ++bj) { const v4u xr1 = xra[ai][m][bj]; const unsigned xw_[4] = {xr1.x, xr1.y, xr1.z, xr1.w}; float o[8];
                    f32x4 av[2] = {acc[ai][bj][m][0], acc[ai][bj][m][1]};
                    if constexpr (Q8) {
#pragma unroll
                        for (int n = 0; n < 2; ++n) { const pg8::i32x4 iv = __builtin_bit_cast(pg8::i32x4, acc[ai][bj][m][n]);
#pragma unroll
                            for (int j = 0; j < 4; ++j) av[n][j] = (float)iv[j] * (rsv[ai][m] * bsv[bj][n][j]); } }
#pragma unroll
                    for (int e = 0; e < 8; ++e) { const float xv = __builtin_bit_cast(float, (e & 1) ? (xw_[e >> 1] & 0xffff0000u) : (xw_[e >> 1] << 16)); o[e] = xv + av[e >> 2][e & 3] + bv[bj][e >> 2][e & 3]; }
                    if (out) { *(f32x4*)(out + off + bj * 128) = (f32x4){o[0], o[1], o[2], o[3]}; *(f32x4*)(out + off + bj * 128 + 4) = (f32x4){o[4], o[5], o[6], o[7]};
#pragma unroll
                        for (int e = 0; e < 8; ++e) sq += o[e] * o[e]; }
                    else { v4u w; w.x = pk2(o[0], o[1]); w.y = pk2(o[2], o[3]); w.z = pk2(o[4], o[5]); w.w = pk2(o[6], o[7]); *(v4u*)(xb + off + bj * 128) = w;
                        const unsigned ww_[4] = {w.x, w.y, w.z, w.w};
#pragma unroll
                        for (int e = 0; e < 8; ++e) { const float xv = __builtin_bit_cast(float, (e & 1) ? (ww_[e >> 1] & 0xffff0000u) : (ww_[e >> 1] << 16)); sq += xv * xv; } } }
                sq += __shfl_xor(sq, 16); sq += __shfl_xor(sq, 32);
                if (fq == 0) __hip_atomic_fetch_add(ss + r, ss_fix(sq), RLX_AGENT);
                asm volatile("" ::: "memory"); }
        }
    }
};
typedef EpiResT<false> EpiRes;
struct EpiSwiGLU {
    static constexpr bool PERM = true, AFTER_DRAIN = false;
    bf16* H; const ssq_t* ss;
    __device__ __forceinline__ void operator()(const f32x4 (&acc)[2][2][4][2], const Unit& u, int wr, int wc, int fr, int fq) const {
        const int row0 = u.pm * 256 + wr * 64 + fr, col0 = u.pn * 128 + wc * 32 + 8 * fq;
        float rsv[2][4];
#pragma unroll
        for (int ai = 0; ai < 2; ++ai)
#pragma unroll
            for (int m = 0; m < 4; ++m) rsv[ai][m] = ss_rstd(ss, row0 + ai * 128 + m * 16);
#pragma unroll
        for (int ai = 0; ai < 2; ++ai)
#pragma unroll
            for (int m = 0; m < 4; ++m) { const int r = row0 + ai * 128 + m * 16; const float rs = rsv[ai][m];
                float hv[8];
#pragma unroll
                for (int n = 0; n < 2; ++n)
#pragma unroll
                    for (int j = 0; j < 4; ++j) { const float g = acc[ai][0][m][n][j] * rs, up = acc[ai][1][m][n][j] * rs; hv[4 * n + j] = siluf_(g) * up; }
                v4u w; w.x = pk2(hv[0], hv[1]); w.y = pk2(hv[2], hv[3]); w.z = pk2(hv[4], hv[5]); w.w = pk2(hv[6], hv[7]);
                *(v4u*)(H + (size_t)r * DFF + col0) = w; }
    }
};
struct EpiSwiGLUQ {
    static constexpr bool PERM = true, AFTER_DRAIN = false;
    bf16* H; const float* ra; const float* bs;
    __device__ __forceinline__ void operator()(const f32x4 (&acc)[2][2][4][2], const Unit& u, int wr, int wc, int fr, int fq) const {
        const int row0 = u.pm * 256 + wr * 64 + fr, col0 = u.pn * 128 + wc * 32 + 8 * fq, bcol0 = u.pn * 256 + wc * 32 + 8 * fq;
        f32x4 bv[2][2]; float rsv[2][4];
#pragma unroll
        for (int bj = 0; bj < 2; ++bj)
#pragma unroll
            for (int n = 0; n < 2; ++n) bv[bj][n] = *(const f32x4*)(bs + bcol0 + bj * 128 + 4 * n);
#pragma unroll
        for (int ai = 0; ai < 2; ++ai)
#pragma unroll
            for (int m = 0; m < 4; ++m) rsv[ai][m] = ra[row0 + ai * 128 + m * 16];
#pragma unroll
        for (int ai = 0; ai < 2; ++ai)
#pragma unroll
            for (int m = 0; m < 4; ++m) { const int r = row0 + ai * 128 + m * 16; const float rs = rsv[ai][m];
                float hv[8];
#pragma unroll
                for (int n = 0; n < 2; ++n)
                {   const pg8::i32x4 gi = __builtin_bit_cast(pg8::i32x4, acc[ai][0][m][n]), ui = __builtin_bit_cast(pg8::i32x4, acc[ai][1][m][n]);
#pragma unroll
                    for (int j = 0; j < 4; ++j) { const float g = (float)gi[j] * (rs * bv[0][n][j]), up = (float)ui[j] * (rs * bv[1][n][j]);
                        hv[4 * n + j] = siluf_(g) * up; } }
                v4u w; w.x = pk2(hv[0], hv[1]); w.y = pk2(hv[2], hv[3]); w.z = pk2(hv[4], hv[5]); w.w = pk2(hv[6], hv[7]);
                *(v4u*)(H + (size_t)r * DFF + col0) = w; }
    }
};
struct EpiHgrnIn {
    static constexpr bool PERM = true, AFTER_DRAIN = false;
    bf16 *QT, *KT, *VI, *GS; float* DEC; const float* lb; const ssq_t* ss;
    __device__ __forceinline__ void operator()(f32x4 (&acc)[2][2][4][2], const Unit& u, int wr, int wc, int fr, int fq) const {
        const int row0 = u.pm * 256 + wr * 64 + fr;
        const int head = 4 * (u.pn >> 3) + (u.pn & 3);
        float rsv[2][4];
#pragma unroll
        for (int ai = 0; ai < 2; ++ai)
#pragma unroll
            for (int m = 0; m < 4; ++m) rsv[ai][m] = ss_rstd(ss, row0 + ai * 128 + m * 16);
        if (u.pn & 4) {
            const int col0 = head * 128 + wc * 32 + 8 * fq;
#pragma unroll
            for (int ai = 0; ai < 2; ++ai)
#pragma unroll
                for (int m = 0; m < 4; ++m) { const int r = row0 + ai * 128 + m * 16; const float rs = rsv[ai][m];
                    float a[8], g[8];
#pragma unroll
                    for (int n = 0; n < 2; ++n)
#pragma unroll
                        for (int j = 0; j < 4; ++j) { a[4 * n + j] = acc[ai][0][m][n][j] * rs; g[4 * n + j] = siluf_(acc[ai][1][m][n][j] * rs); }
                    v4u w; w.x = pk2(a[0], a[1]); w.y = pk2(a[2], a[3]); w.z = pk2(a[4], a[5]); w.w = pk2(a[6], a[7]); *(v4u*)(VI + (size_t)r * D + col0) = w;
                    w.x = pk2(g[0], g[1]); w.y = pk2(g[2], g[3]); w.z = pk2(g[4], g[5]); w.w = pk2(g[6], g[7]); *(v4u*)(GS + (size_t)r * D + col0) = w; }
            return;
        }
        const int col0 = head * 128 + wc * 32 + 8 * fq;
#pragma unroll
        for (int ai = 0; ai < 2; ++ai) {
            v2u hq[4], hk[4];
#pragma unroll
            for (int n = 0; n < 2; ++n) {
                float pf[4][4], lbv[4];
#pragma unroll
                for (int j = 0; j < 4; ++j) lbv[j] = 1.0f - lb[col0 + 4 * n + j];
#pragma unroll
                for (int m = 0; m < 4; ++m) { const float rs = rsv[ai][m];
#pragma unroll
                    for (int j = 0; j < 4; ++j) { const float ex = fast_exp2(acc[ai][1][m][n][j] * rs * LOG2E);
                        const float k1 = lbv[j] * fast_rcp(1.0f + ex);
                        acc[ai][1][m][n][j] = k1; pf[m][j] = 1.0f - k1;
                        acc[ai][0][m][n][j] = siluf_(acc[ai][0][m][n][j] * rs) * 0.08838834764831845f; }
                    __builtin_amdgcn_sched_barrier(0); }
                float run[4] = {1.f, 1.f, 1.f, 1.f};
#pragma unroll
                for (int m = 0; m < 4; ++m)
#pragma unroll
                    for (int j = 0; j < 4; ++j) { float v = pf[m][j];
                        v *= __builtin_bit_cast(float, __builtin_amdgcn_update_dpp(0x3f800000, __builtin_bit_cast(int, v), 0x111, 0xf, 0xf, false));
                        v *= __builtin_bit_cast(float, __builtin_amdgcn_update_dpp(0x3f800000, __builtin_bit_cast(int, v), 0x112, 0xf, 0xf, false));
                        v *= __builtin_bit_cast(float, __builtin_amdgcn_update_dpp(0x3f800000, __builtin_bit_cast(int, v), 0x114, 0xf, 0xf, false));
                        v *= __builtin_bit_cast(float, __builtin_amdgcn_update_dpp(0x3f800000, __builtin_bit_cast(int, v), 0x118, 0xf, 0xf, false));
                        const float tot = __shfl(v, 15, 16); pf[m][j] = v * run[j]; run[j] *= tot; }
#pragma unroll
                for (int m = 0; m < 4; ++m) { const int r = row0 + ai * 128 + m * 16; float qt[4], kt[4];
#pragma unroll
                    for (int j = 0; j < 4; ++j) { const float p = pf[m][j]; const float k1 = acc[ai][1][m][n][j];
                        qt[j] = acc[ai][0][m][n][j] * p; kt[j] = k1 * fast_rcp(p); }
                    v2u wq, wk; const unsigned off = (unsigned)r * D + col0;
                    wq.x = pk2(qt[0], qt[1]); wq.y = pk2(qt[2], qt[3]); wk.x = pk2(kt[0], kt[1]); wk.y = pk2(kt[2], kt[3]);
                    if (n == 0) { hq[m] = wq; hk[m] = wk; }
                    else { *(v4u*)(QT + off) = (v4u){hq[m].x, hq[m].y, wq.x, wq.y}; *(v4u*)(KT + off) = (v4u){hk[m].x, hk[m].y, wk.x, wk.y}; }
                    __builtin_amdgcn_sched_barrier(0); }
                if (fr == 0) { const int chunk = u.pm * 4 + ai * 2 + wr; *(f32x4*)(DEC + (unsigned)chunk * D + col0 + 4 * n) = (f32x4){run[0], run[1], run[2], run[3]}; }
                asm volatile("" ::: "memory");
            } }
    }
};

__device__ __forceinline__ int dst_row(int map, int n) {
    if (map == 0) return n;
    if (map == 1) { const int up = n >= DFF ? 1 : 0, j = n - up * DFF; return 256 * (j >> 7) + 128 * up + (j & 127); }
    const int part = n >> 12, j = n & 4095, head = j >> 7, d = j & 127; return 256 * (8 * (head >> 2) + 4 * (part >> 1) + (head & 3)) + 128 * (part & 1) + d;
}
struct CvItem { const float* W; bf16* WT; const float* kw; int K, N, map, item; };
__device__ __forceinline__ void cv_load(const CvItem& c, int lane, float (&v)[32], float& kwa) {
    const int nblk = c.N / 32, kb = c.item / nblk, nb = c.item % nblk, k0 = 64 * kb, n0 = 32 * nb;
    kwa = c.kw ? c.kw[k0 + lane] : 1.0f;
    const float* src = c.W + (size_t)(k0 + (lane >> 5)) * c.N + n0 + (lane & 31);
#pragma unroll
    for (int i = 0; i < 32; ++i) v[i] = __builtin_nontemporal_load(src + (size_t)(2 * i) * c.N);
}
__device__ __forceinline__ void cv_store(const CvItem& c, int lane, const float (&v)[32], float kwa, LAS float* scr) {
    const int nblk = c.N / 32, kb = c.item / nblk, nb = c.item % nblk, k0 = 64 * kb, n0 = 32 * nb;
#pragma unroll
    for (int i = 0; i < 32; ++i) { const int kk = 2 * i + (lane >> 5); scr[kk * 33 + (lane & 31)] = v[i] * __shfl(kwa, kk); }
    LDS_WAIT(); asm volatile("" ::: "memory");
    const int cc = lane & 7; const int r0 = dst_row(c.map, n0);
#pragma unroll
    for (int j = 0; j < 4; ++j) { const int n = (lane >> 3) + 8 * j; const LAS float* s = scr + (8 * cc) * 33 + n;
        v4u o; o.x = pk2(s[0 * 33], s[1 * 33]); o.y = pk2(s[2 * 33], s[3 * 33]); o.z = pk2(s[4 * 33], s[5 * 33]); o.w = pk2(s[6 * 33], s[7 * 33]);
        __builtin_nontemporal_store(o, (GAS v4u*)(c.WT + (size_t)(r0 + n) * c.K + k0 + 8 * cc)); }
    LDS_WAIT(); asm volatile("" ::: "memory");
}
__device__ __forceinline__ void row_to_bf16_ss(const float* xrow, bf16* orow, ssq_t* ssrow, int lane, signed char* qrow = nullptr, float* qscale = nullptr) {
    const GAS f32x4* xr = (const GAS f32x4*)xrow + lane;
    f32x4 v[16]; float s = 0.f;
#pragma unroll
    for (int j = 0; j < 16; ++j) { v[j] = xr[64 * j]; s += (v[j].x * v[j].x + v[j].y * v[j].y) + (v[j].z * v[j].z + v[j].w * v[j].w); }
    s = wave_sum(s);
    if (qrow) {
        float amax = 0.f;
#pragma unroll
        for (int j = 0; j < 16; ++j) amax = fmaxf(fmaxf(amax, fmaxf(fabsf(v[j].x), fabsf(v[j].y))), fmaxf(fabsf(v[j].z), fabsf(v[j].w)));
        amax = wave_max(amax); const float inv = amax > 0.f ? 127.0f / amax : 0.f;
        GAS unsigned* q4 = (GAS unsigned*)qrow + lane;
#pragma unroll
        for (int j = 0; j < 16; ++j) { const int a = (int)__builtin_rintf(v[j].x * inv), b = (int)__builtin_rintf(v[j].y * inv), c = (int)__builtin_rintf(v[j].z * inv), d = (int)__builtin_rintf(v[j].w * inv);
            q4[64 * j] = (unsigned)(a & 255) | ((unsigned)(b & 255) << 8) | ((unsigned)(c & 255) << 16) | ((unsigned)(d & 255) << 24); }
        if (lane == 0) *qscale = amax * (1.0f / 127.0f) * __builtin_amdgcn_rsqf(s * (1.0f / D) + RMS_EPS);
    }
    GAS v2u* o8 = (GAS v2u*)orow + lane;
#pragma unroll
    for (int j = 0; j < 16; ++j) { v2u p; p.x = pk2(v[j].x, v[j].y); p.y = pk2(v[j].z, v[j].w); o8[64 * j] = p; }
    if (lane == 0) *ssrow = ss_fix(s);
}

template <int NBK> __device__ __forceinline__ void sgemm_unit(const bf16* A, int K, const bf16* B0, const bf16* B1, LAS float* red, int wave, int lane, int tid, float (&out)[NBK]) {
    const int fr = lane & 15, fq = lane >> 4;
    f32x4 acc[NBK][2];
#pragma unroll
    for (int nb = 0; nb < NBK; ++nb) { acc[nb][0] = (f32x4){0.f, 0.f, 0.f, 0.f}; acc[nb][1] = (f32x4){0.f, 0.f, 0.f, 0.f}; }
    const bf16* a0p = A + (size_t)fr * K + fq * 32; const bf16* a1p = a0p + (size_t)16 * K;
    const bf16* b0p = B0 + (size_t)fr * K + fq * 32; const bf16* b1p = B1 + (size_t)fr * K + fq * 32;
    const int ns = K >> 7;
    for (int s = wave; s < ns; s += 24) {
        bf16x8 a0[3][4], a1[3][4], b0[3][4], b1[3][4];
#pragma unroll
        for (int g = 0; g < 3; ++g) { const int sg = s + 8 * g < ns ? s + 8 * g : s; const int off = sg * 128;
#pragma unroll
            for (int j = 0; j < 4; ++j) { a0[g][j] = *(const bf16x8*)(a0p + off + 8 * j); a1[g][j] = *(const bf16x8*)(a1p + off + 8 * j); b0[g][j] = *(const bf16x8*)(b0p + off + 8 * j); if (NBK > 1) b1[g][j] = *(const bf16x8*)(b1p + off + 8 * j); } }
#pragma unroll
        for (int g = 0; g < 3; ++g) { if (s + 8 * g < ns) {
#pragma unroll
            for (int j = 0; j < 4; ++j) { acc[0][0] = MFMA16(b0[g][j], a0[g][j], acc[0][0]); acc[0][1] = MFMA16(b0[g][j], a1[g][j], acc[0][1]);
                if (NBK > 1) { acc[NBK - 1][0] = MFMA16(b1[g][j], a0[g][j], acc[NBK - 1][0]); acc[NBK - 1][1] = MFMA16(b1[g][j], a1[g][j], acc[NBK - 1][1]); } } } }
    }
#pragma unroll
    for (int nb = 0; nb < NBK; ++nb)
#pragma unroll
        for (int rb = 0; rb < 2; ++rb) *(LAS f32x4*)(red + (((wave * NBK + nb) * 2 + rb) * 64 + lane) * 4) = acc[nb][rb];
    __syncthreads();
    const int row = tid >> 4, n = tid & 15, rb = row >> 4, lp = (n >> 2) * 16 + (row & 15), rg = n & 3;
#pragma unroll
    for (int nb = 0; nb < NBK; ++nb) { float s = 0.f;
#pragma unroll
        for (int w = 0; w < 8; ++w) s += red[(((w * NBK + nb) * 2 + rb) * 64 + lp) * 4 + rg];
        out[nb] = s; }
    __syncthreads();
}

struct SampleA { bf16x8 a0[4][4], a1[4][4]; };
__device__ __forceinline__ void sample_load_a(SampleA& sa, const bf16* A, int wave, int lane) {
    const int fr = lane & 15, fq = lane >> 4; const bf16* p = A + (size_t)fr * D + fq * 32 + wave * 128;
#pragma unroll
    for (int s = 0; s < 4; ++s)
#pragma unroll
        for (int j = 0; j < 4; ++j) { sa.a0[s][j] = *(const bf16x8*)(p + s * 1024 + 8 * j); sa.a1[s][j] = *(const bf16x8*)(p + (size_t)16 * D + s * 1024 + 8 * j); }
}
template <int NBK> __device__ __forceinline__ void sgemm_unit_ra(const SampleA& sa, const bf16* B0, const bf16* B1, LAS float* red, int wave, int lane, int tid, float (&out)[NBK]) {
    const int fr = lane & 15, fq = lane >> 4;
#pragma unroll
    for (int nb = 0; nb < NBK; ++nb) { const bf16* bp = (nb == 0 ? B0 : B1) + (size_t)fr * D + fq * 32 + wave * 128;
        bf16x8 b[4][4];
#pragma unroll
        for (int s = 0; s < 4; ++s)
#pragma unroll
            for (int j = 0; j < 4; ++j) b[s][j] = *(const bf16x8*)(bp + s * 1024 + 8 * j);
        f32x4 c0 = (f32x4){0.f, 0.f, 0.f, 0.f}, c1 = (f32x4){0.f, 0.f, 0.f, 0.f};
#pragma unroll
        for (int s = 0; s < 4; ++s)
#pragma unroll
            for (int j = 0; j < 4; ++j) { c0 = MFMA16(b[s][j], sa.a0[s][j], c0); c1 = MFMA16(b[s][j], sa.a1[s][j], c1); }
        *(LAS f32x4*)(red + (((wave * NBK + nb) * 2 + 0) * 64 + lane) * 4) = c0; *(LAS f32x4*)(red + (((wave * NBK + nb) * 2 + 1) * 64 + lane) * 4) = c1; }
    __syncthreads();
    const int row = tid >> 4, n = tid & 15, rb = row >> 4, lp = (n >> 2) * 16 + (row & 15), rg = n & 3;
#pragma unroll
    for (int nb = 0; nb < NBK; ++nb) { float s = 0.f;
#pragma unroll
        for (int w = 0; w < 8; ++w) s += red[(((w * NBK + nb) * 2 + rb) * 64 + lp) * 4 + rg];
        out[nb] = s; }
    __syncthreads();
}

typedef int v4i_t __attribute__((ext_vector_type(4)));
struct SampleA8 { v4i_t a0[2][4], a1[2][4]; };
__device__ __forceinline__ void sample_load_a8(SampleA8& sa, const signed char* A, int wave, int lane) {
    const int fr = lane & 15, fq = lane >> 4; const signed char* p = A + (size_t)fr * D + fq * 64 + wave * 256;
#pragma unroll
    for (int s = 0; s < 2; ++s)
#pragma unroll
        for (int j = 0; j < 4; ++j) { sa.a0[s][j] = *(const v4i_t*)(p + s * 2048 + 16 * j); sa.a1[s][j] = *(const v4i_t*)(p + (size_t)16 * D + s * 2048 + 16 * j); }
}
__device__ __forceinline__ void sgemm_unit_i8x2(const SampleA8& sa, const signed char* B0, const signed char* B1, LAS float* red, int wave, int lane, int tid, float (&out)[2]) {
    const int fr = lane & 15, fq = lane >> 4;
    v4i_t b[2][2][4];
#pragma unroll
    for (int nb = 0; nb < 2; ++nb) { const signed char* bp = (nb == 0 ? B0 : B1) + (size_t)fr * D + fq * 64 + wave * 256;
#pragma unroll
        for (int s = 0; s < 2; ++s)
#pragma unroll
            for (int j = 0; j < 4; ++j) b[nb][s][j] = *(const v4i_t*)(bp + s * 2048 + 16 * j); }
#pragma unroll
    for (int nb = 0; nb < 2; ++nb) { v4i_t c0 = (v4i_t){0, 0, 0, 0}, c1 = (v4i_t){0, 0, 0, 0};
#pragma unroll
        for (int s = 0; s < 2; ++s)
#pragma unroll
            for (int j = 0; j < 4; ++j) { c0 = __builtin_amdgcn_mfma_i32_16x16x64_i8(b[nb][s][j], sa.a0[s][j], c0, 0, 0, 0); c1 = __builtin_amdgcn_mfma_i32_16x16x64_i8(b[nb][s][j], sa.a1[s][j], c1, 0, 0, 0); }
        *(LAS v4i_t*)(red + (((wave * 2 + nb) * 2 + 0) * 64 + lane) * 4) = c0; *(LAS v4i_t*)(red + (((wave * 2 + nb) * 2 + 1) * 64 + lane) * 4) = c1; }
    __syncthreads();
    const int row = tid >> 4, n = tid & 15, rb = row >> 4, lp = (n >> 2) * 16 + (row & 15), rg = n & 3;
#pragma unroll
    for (int nb = 0; nb < 2; ++nb) { int s = 0;
#pragma unroll
        for (int w = 0; w < 8; ++w) s += ((const LAS int*)red)[(((w * 2 + nb) * 2 + rb) * 64 + lp) * 4 + rg];
        out[nb] = (float)s; }
    __syncthreads();
}

#define LDS_BARRIER() do { asm volatile("s_waitcnt lgkmcnt(0)" ::: "memory"); __builtin_amdgcn_s_barrier(); asm volatile("" ::: "memory"); } while (0)
constexpr int AT_KS = 144, AT_VS = 192, AT_KOFF = 0, AT_VOFF = 256 * AT_KS;
static_assert(AT_VOFF + 256 * AT_VS <= RING_BYTES, "attention LDS");
struct AttnKV { v4u k[4], v[4]; };
__device__ __forceinline__ void attn_kv_load(AttnKV& t, const bf16* Kb, const bf16* Vb, int b, int hkv, int n, int tid) {
    const int r0 = b * SEQ + n * 128;
#pragma unroll
    for (int i = 0; i < 4; ++i) { const int p = tid + 512 * i, key = p >> 3, ch = p & 7; const int gr = r0 - 128 + key; t.k[i] = (v4u){0u, 0u, 0u, 0u}; t.v[i] = (v4u){0u, 0u, 0u, 0u};
        if (n > 0 || key >= 128) { t.k[i] = *(const v4u*)(Kb + (size_t)gr * KVD + hkv * 64 + ch * 8); t.v[i] = *(const v4u*)(Vb + (size_t)gr * KVD + hkv * 64 + ch * 8); } }
}
__device__ __forceinline__ void attn_kv_store(const AttnKV& t, LAS unsigned char* lds, int tid) {
#pragma unroll
    for (int i = 0; i < 4; ++i) { const int p = tid + 512 * i, key = p >> 3, ch = p & 7; *(LAS v4u*)(lds + AT_KOFF + key * AT_KS + ch * 16) = t.k[i]; *(LAS v4u*)(lds + AT_VOFF + key * AT_VS + ch * 16) = t.v[i]; }
}
__device__ __forceinline__ void attn_prompt_unit(LAS unsigned char* lds, const bf16* Q, const bf16* Kb, const bf16* Vb, bf16* O, const float* sinks, int b, int hkv, int n, AttnKV& kv, bool has_next, int nb, int nhkv, int nn, int tid, int wave, int lane) {
    const int r0 = b * SEQ + n * 128;
    LDS_BARRIER();
    attn_kv_store(kv, lds, tid);
    LDS_BARRIER();
    const int hq = hkv * 8 + wave, h = lane >> 5, l31 = lane & 31, i16 = lane & 15, q4 = i16 >> 2, p4 = i16 & 3, blk = (lane >> 4) & 1;
    const float sink2 = sinks[hq] * LOG2E; const float sc2 = 0.125f * LOG2E; const float ninf = -__builtin_inff();
    bf16x8 qf[4], qn[4];
    { const bf16* qp = Q + (size_t)(r0 + l31) * D + hq * 64 + 8 * h;
#pragma unroll
      for (int ks = 0; ks < 4; ++ks) qf[ks] = *(const bf16x8*)(qp + ks * 16); }
    for (int qs = 0; qs < 4; ++qs) {
        if (qs < 3) { const bf16* qp = Q + (size_t)(r0 + (qs + 1) * 32 + l31) * D + hq * 64 + 8 * h;
#pragma unroll
            for (int ks = 0; ks < 4; ++ks) qn[ks] = *(const bf16x8*)(qp + ks * 16); }
        else if (has_next) attn_kv_load(kv, Kb, Vb, nb, nhkv, nn, tid);
        f32x16 st[5];
        const int qi = qs * 32 + l31; float mx = sink2;
        const LAS unsigned char* kbase = lds + AT_KOFF + (qs * 32 + l31) * AT_KS + 16 * h;
#pragma unroll
        for (int i = 0; i < 5; ++i) { f32x16 a;
#pragma unroll
            for (int r = 0; r < 16; ++r) a[r] = 0.f;
#pragma unroll
            for (int ks = 0; ks < 4; ++ks) { const bf16x8 kf = *(const LAS bf16x8*)(kbase + i * 32 * AT_KS + ks * 32); a = MFMA32(kf, qf[ks], a); }
            const bool prevblk = (qs + i) < 4;
            if (prevblk && n == 0) {
#pragma unroll
                for (int r = 0; r < 16; ++r) a[r] = ninf;
            } else if (i == 0) {
#pragma unroll
                for (int r = 0; r < 16; ++r) { const float s = (crow(r, h) > l31) ? a[r] * sc2 : ninf; a[r] = s; mx = fmaxf(mx, s); }
            } else if (i == 4) {
#pragma unroll
                for (int r = 0; r < 16; ++r) { const float s = (crow(r, h) <= l31) ? a[r] * sc2 : ninf; a[r] = s; mx = fmaxf(mx, s); }
            } else {
#pragma unroll
                for (int r = 0; r < 16; ++r) { const float s = a[r] * sc2; a[r] = s; mx = fmaxf(mx, s); }
            }
            st[i] = a; }
        mx = fmaxf(mx, __shfl_xor(mx, 32));
        float sum = 0.f;
#pragma unroll
        for (int i = 0; i < 5; ++i)
#pragma unroll
            for (int r = 0; r < 16; ++r) { const float p = fast_exp2(st[i][r] - mx); st[i][r] = p; sum += p; }
        sum += __shfl_xor(sum, 32);
        const float inv = fast_rcp(sum + fast_exp2(sink2 - mx));
        f32x16 oa[2];
#pragma unroll
        for (int r = 0; r < 16; ++r) { oa[0][r] = 0.f; oa[1][r] = 0.f; }
        const LAS unsigned char* vbase = lds + AT_VOFF + (qs * 32 + 4 * h + q4) * AT_VS + 32 * blk + 8 * p4;
#pragma unroll
        for (int i = 0; i < 5; ++i)
#pragma unroll
            for (int s = 0; s < 2; ++s) { v4u pw; pw.x = pk2(st[i][8 * s + 0], st[i][8 * s + 1]); pw.y = pk2(st[i][8 * s + 2], st[i][8 * s + 3]); pw.z = pk2(st[i][8 * s + 4], st[i][8 * s + 5]); pw.w = pk2(st[i][8 * s + 6], st[i][8 * s + 7]);
                const bf16x8 pf = __builtin_bit_cast(bf16x8, pw);
#pragma unroll
                for (int db = 0; db < 2; ++db) { const LAS unsigned char* vp = vbase + (i * 32 + 16 * s) * AT_VS + db * 64;
                    const bf16x8 vf = tr_frag(vp, vp + 8 * AT_VS); oa[db] = MFMA32(vf, pf, oa[db]); } }
        bf16* op = O + (size_t)(r0 + qs * 32 + l31) * D + hq * 64;
#pragma unroll
        for (int db = 0; db < 2; ++db)
#pragma unroll
            for (int g4 = 0; g4 < 4; ++g4) { v2u w; w.x = pk2(oa[db][4 * g4] * inv, oa[db][4 * g4 + 1] * inv); w.y = pk2(oa[db][4 * g4 + 2] * inv, oa[db][4 * g4 + 3] * inv); *(v2u*)(op + db * 32 + 8 * g4 + 4 * h) = w; }
#pragma unroll
        for (int ks = 0; ks < 4; ++ks) qf[ks] = qn[ks];
    }
}
__device__ __forceinline__ void attn_sample_unit(LAS unsigned char* lds, const bf16* Q, const bf16* Kb, const bf16* Vb, bf16* O, const float* sinks, const float* ck, const float* cv, float* wks, float* wvs, int sb, int hkv, int tid, int wave, int lane) {
    LAS float* Ks = (LAS float*)lds; LAS float* Vs = Ks + 128 * 65; LAS float* qs = Vs + 128 * 64; LAS float* sc = qs + 512;
    __syncthreads();
#pragma unroll 4
    for (int i = 0; i < 16; ++i) { const int idx = tid + 512 * i, j = idx >> 6, d = idx & 63; float kv, vv;
        if (j < 127) { const size_t g = ((size_t)(sb * 128 + j + 1) * 8 + hkv) * 64 + d; kv = ck[g]; vv = cv[g]; const size_t o = ((size_t)(sb * 128 + j) * 8 + hkv) * 64 + d; wks[o] = kv; wvs[o] = vv; }
        else { kv = bf2f(Kb[(size_t)(MP + sb) * KVD + hkv * 64 + d]); vv = bf2f(Vb[(size_t)(MP + sb) * KVD + hkv * 64 + d]); }
        Ks[j * 65 + d] = kv; Vs[j * 64 + d] = vv; }
    qs[tid] = bf2f(Q[(size_t)(MP + sb) * D + hkv * 512 + tid]);
    __syncthreads();
#pragma unroll
    for (int i = 0; i < 2; ++i) { const int idx = tid + 512 * i, g = idx >> 7, j = idx & 127; float s = 0.f;
#pragma unroll 16
        for (int d = 0; d < 64; ++d) s += qs[g * 64 + d] * Ks[j * 65 + d];
        sc[idx] = s * 0.125f; }
    __syncthreads();
    { const float snk = sinks[hkv * 8 + wave]; const float s0 = sc[wave * 128 + lane], s1 = sc[wave * 128 + 64 + lane];
      const float m = fmaxf(wave_max(fmaxf(s0, s1)), snk); const float e0 = __expf(s0 - m), e1 = __expf(s1 - m); const float den = wave_sum(e0 + e1) + __expf(snk - m);
      sc[wave * 128 + lane] = e0 / den; sc[wave * 128 + 64 + lane] = e1 / den; }
    __syncthreads();
    { const int g = tid >> 6, d = tid & 63; float o = 0.f;
#pragma unroll 16
      for (int j = 0; j < 128; ++j) o += sc[g * 128 + j] * Vs[j * 64 + d];
      O[(size_t)(MP + sb) * D + hkv * 512 + tid] = (bf16)(pk2(o, 0.f) & 0xffffu); }
}

__device__ __forceinline__ void quant_load(v4u (&x)[8], const bf16* src, int lane) {
#pragma unroll
    for (int i = 0; i < 8; ++i) x[i] = *(const v4u*)(src + (i * 64 + lane) * 8);
}
__device__ __forceinline__ void quant_finish(const v4u (&x)[8], signed char* dst, float* scale_out, float extra, int lane) {
    float amax = 0.f;
#pragma unroll
    for (int i = 0; i < 8; ++i) { const unsigned w_[4] = {x[i].x, x[i].y, x[i].z, x[i].w};
#pragma unroll
        for (int e = 0; e < 4; ++e) { amax = fmaxf(amax, fabsf(__builtin_bit_cast(float, w_[e] << 16))); amax = fmaxf(amax, fabsf(__builtin_bit_cast(float, w_[e] & 0xffff0000u))); } }
    amax = wave_max(amax);
    const float inv = amax > 0.f ? 127.0f / amax : 0.f;
#pragma unroll
    for (int i = 0; i < 8; ++i) { const unsigned w_[4] = {x[i].x, x[i].y, x[i].z, x[i].w}; unsigned q[2] = {0u, 0u};
#pragma unroll
        for (int e = 0; e < 4; ++e) { const int a = (int)__builtin_rintf(__builtin_bit_cast(float, w_[e] << 16) * inv), b = (int)__builtin_rintf(__builtin_bit_cast(float, w_[e] & 0xffff0000u) * inv);
            q[e >> 1] |= ((unsigned)(a & 255) | ((unsigned)(b & 255) << 8)) << (16 * (e & 1)); }
        *(v2u*)(dst + (i * 64 + lane) * 8) = (v2u){q[0], q[1]}; }
    if (lane == 0) *scale_out = amax * (1.0f / 127.0f) * extra;
}
__device__ __forceinline__ void quant_row_i8(const bf16* src, signed char* dst, float* scale_out, float extra, int lane) { v4u x[8]; quant_load(x, src, lane); quant_finish(x, dst, scale_out, extra, lane); }
template <class F> __device__ __forceinline__ void quant_rows_i8(int r0, int rend, int rstep, int lane, F f) {
    if (r0 >= rend) return;
    v4u xa[8], xb[8]; const bf16* src; signed char *da, *db; float *sa, *sb; float ea, eb;
    int r = r0; f(r, src, da, sa, ea); quant_load(xa, src, lane);
    for (;;) {
        const int r1 = r + rstep; const bool h1 = r1 < rend;
        if (h1) { f(r1, src, db, sb, eb); quant_load(xb, src, lane); }
        quant_finish(xa, da, sa, ea, lane);
        if (!h1) break;
        const int r2 = r1 + rstep; const bool h2 = r2 < rend;
        if (h2) { f(r2, src, da, sa, ea); quant_load(xa, src, lane); }
        quant_finish(xb, db, sb, eb, lane);
        if (!h2) break;
        r = r2;
    }
}

constexpr int GL_QT = 0, GL_KT = 17408, GL_KP = 34816, GL_V = 55296, GL_AM = 75776, GL_ST = 84992, GL_DEC = 119808, GL_PART = 120320, GL_END = 121344;
constexpr int GS_R = 272, GS_T = 320, GS_A = 144;
static_assert(GL_END <= RING_BYTES && GL_KT == 64 * GS_R && GL_KP == GL_KT + 64 * GS_R && GL_V == GL_KP + 64 * GS_T && GL_AM == GL_V + 64 * GS_T && GL_ST == GL_AM + 64 * GS_A && GL_DEC == GL_ST + 128 * GS_R, "GLA LDS map");
__device__ __forceinline__ void gla_prompt_seq(LAS unsigned char* lds, const bf16* QT, const bf16* KT, const bf16* VI, const bf16* GS, const float* DEC, const float* nw, bf16* OG, float* state_out,
                                               int b, int hh, int tid, int wave, int lane) {
    const int h = lane >> 5, l31 = lane & 31, i16 = lane & 15, q4 = i16 >> 2, p4 = i16 & 3, blk = (lane >> 4) & 1;
    const int kb = wave >> 1, vb0 = 2 * (wave & 1);
    const int tb = wave >> 2, vbo = wave & 3;
    __syncthreads();
    for (int i = tid * 16; i < GL_DEC - GL_AM; i += 512 * 16) *(LAS v4u*)(lds + GL_AM + i) = (v4u){0u, 0u, 0u, 0u};
    f32x16 S0, S1;
#pragma unroll
    for (int r = 0; r < 16; ++r) { S0[r] = 0.f; S1[r] = 0.f; }
    float nwv[16];
#pragma unroll
    for (int r = 0; r < 16; ++r) nwv[r] = nw[vbo * 32 + crow(r, h)];
    const int lrow0 = tid >> 4, lc16 = tid & 15; const int R0 = b * SEQ; const size_t gcol = (size_t)hh * 128 + lc16 * 8;
    v4u pqA[2], pkA[2], pvA[2], pqB[2], pkB[2], pvB[2]; float pdA = 0.f, pdB = 0.f; v2u gsE[4], gsO[4];
#define GLA_LOAD(X, c) do { if ((c) < 32) { _Pragma("unroll") for (int i_ = 0; i_ < 2; ++i_) { const size_t g_ = (size_t)(R0 + (c) * 64 + lrow0 + 32 * i_) * D + gcol; \
        pq##X[i_] = *(const v4u*)(QT + g_); pk##X[i_] = *(const v4u*)(KT + g_); pv##X[i_] = *(const v4u*)(VI + g_); } \
        if (tid < 128) pd##X = DEC[(size_t)(b * 32 + (c)) * D + hh * 128 + tid]; } } while (0)
#define GLA_STORE(X) do { _Pragma("unroll") for (int i_ = 0; i_ < 2; ++i_) { const int r_ = lrow0 + 32 * i_; \
        *(LAS v4u*)(lds + GL_QT + r_ * GS_R + lc16 * 16) = pq##X[i_]; *(LAS v4u*)(lds + GL_KT + r_ * GS_R + lc16 * 16) = pk##X[i_]; \
        *(LAS v4u*)(lds + GL_KP + r_ * GS_T + lc16 * 16) = pk##X[i_]; *(LAS v4u*)(lds + GL_V + r_ * GS_T + lc16 * 16) = pv##X[i_]; } \
        if (tid < 128) *(LAS float*)(lds + GL_DEC + tid * 4) = pd##X; } while (0)
#define GLA_GS(G, c) do { if ((c) < 32) { _Pragma("unroll") for (int g4_ = 0; g4_ < 4; ++g4_) G[g4_] = *(const v2u*)(GS + (size_t)(R0 + (c) * 64 + tb * 32 + l31) * D + hh * 128 + vbo * 32 + 8 * g4_ + 4 * h); } } while (0)
#define GLA_CHUNK(c, X, G) do { \
        LDS_BARRIER();                                                     \
        const int trow = R0 + (c) * 64 + tb * 32 + l31; \
        { bf16x8 kpf[4], vf0[4], vf1[4];                                     \
          _Pragma("unroll") for (int ts = 0; ts < 4; ++ts) { const int t0 = 16 * ts + 8 * h + q4; \
            const LAS unsigned char* ka = lds + GL_KP + t0 * GS_T + (kb * 32 + 16 * blk) * 2 + 8 * p4; kpf[ts] = tr_frag(ka, ka + 4 * GS_T); \
            const LAS unsigned char* va = lds + GL_V + t0 * GS_T + (vb0 * 32 + 16 * blk) * 2 + 8 * p4; vf0[ts] = tr_frag(va, va + 4 * GS_T); vf1[ts] = tr_frag(va + 64, va + 64 + 4 * GS_T); } \
          _Pragma("unroll") for (int ts = 0; ts < 4; ++ts) { S0 = MFMA32(kpf[ts], vf0[ts], S0); S1 = MFMA32(kpf[ts], vf1[ts], S1); } } \
        _Pragma("unroll") for (int r = 0; r < 16; ++r) { const float dc = *(const LAS float*)(lds + GL_DEC + (kb * 32 + crow(r, h)) * 4); S0[r] *= dc; S1[r] *= dc; }     \
        if (wave < 3) { const int tbp = wave > 0 ? 1 : 0, sb = wave == 2 ? 1 : 0; f32x16 a; \
            _Pragma("unroll") for (int r = 0; r < 16; ++r) a[r] = 0.f; \
            bf16x8 kf[8], qf[8]; \
            _Pragma("unroll") for (int ks = 0; ks < 8; ++ks) { kf[ks] = *(const LAS bf16x8*)(lds + GL_KT + (sb * 32 + l31) * GS_R + (ks * 16 + 8 * h) * 2); qf[ks] = *(const LAS bf16x8*)(lds + GL_QT + (tbp * 32 + l31) * GS_R + (ks * 16 + 8 * h) * 2); } \
            _Pragma("unroll") for (int ks = 0; ks < 8; ++ks) a = MFMA32(kf[ks], qf[ks], a); \
            const int t_ = tbp * 32 + l31; \
            _Pragma("unroll") for (int g4 = 0; g4 < 4; ++g4) { float x[4]; \
                _Pragma("unroll") for (int j = 0; j < 4; ++j) { const int sp = sb * 32 + 8 * g4 + 4 * h + j; x[j] = (sp <= t_) ? a[4 * g4 + j] : 0.f; } \
                v2u w; w.x = pk2(x[0], x[1]); w.y = pk2(x[2], x[3]); *(LAS v2u*)(lds + GL_AM + t_ * GS_A + (sb * 32 + 8 * g4 + 4 * h) * 2) = w; } } \
        LDS_BARRIER();                                                     \
        f32x16 o; \
        _Pragma("unroll") for (int r = 0; r < 16; ++r) o[r] = 0.f; \
        const int t = tb * 32 + l31; \
        { bf16x8 sf[8], qf[8], vf[4], af[4]; \
          _Pragma("unroll") for (int ks = 0; ks < 8; ++ks) { sf[ks] = *(const LAS bf16x8*)(lds + GL_ST + (vbo * 32 + l31) * GS_R + (ks * 16 + 8 * h) * 2); qf[ks] = *(const LAS bf16x8*)(lds + GL_QT + t * GS_R + (ks * 16 + 8 * h) * 2); } \
          _Pragma("unroll") for (int ks = 0; ks < 4; ++ks) { const LAS unsigned char* va = lds + GL_V + (16 * ks + 8 * h + q4) * GS_T + (vbo * 32 + 16 * blk) * 2 + 8 * p4; vf[ks] = tr_frag(va, va + 4 * GS_T); \
            af[ks] = *(const LAS bf16x8*)(lds + GL_AM + t * GS_A + (ks * 16 + 8 * h) * 2); } \
          _Pragma("unroll") for (int ks = 0; ks < 8; ++ks) o = MFMA32(sf[ks], qf[ks], o); \
          _Pragma("unroll") for (int ks = 0; ks < 4; ++ks) o = MFMA32(vf[ks], af[ks], o); } \
        float sq = 0.f; \
        _Pragma("unroll") for (int r = 0; r < 16; ++r) sq += o[r] * o[r]; \
        sq += __shfl_xor(sq, 32); \
        if (h == 0) *(LAS float*)(lds + GL_PART + (vbo * 64 + t) * 4) = sq; \
        LDS_BARRIER();                                                     \
        { const LAS float* pp_ = (const LAS float*)(lds + GL_PART); const float tot = (pp_[t] + pp_[64 + t]) + (pp_[128 + t] + pp_[192 + t]); const float rstd = __builtin_amdgcn_rsqf(tot * (1.0f / 128.0f) + RMS_EPS); \
          _Pragma("unroll") for (int g4 = 0; g4 < 4; ++g4) { const float g0 = __builtin_bit_cast(float, G[g4].x << 16), g1 = __builtin_bit_cast(float, G[g4].x & 0xffff0000u), g2 = __builtin_bit_cast(float, G[g4].y << 16), g3 = __builtin_bit_cast(float, G[g4].y & 0xffff0000u); \
              v2u w; w.x = pk2(o[4 * g4] * rstd * nwv[4 * g4] * g0, o[4 * g4 + 1] * rstd * nwv[4 * g4 + 1] * g1); w.y = pk2(o[4 * g4 + 2] * rstd * nwv[4 * g4 + 2] * g2, o[4 * g4 + 3] * rstd * nwv[4 * g4 + 3] * g3); \
              *(v2u*)(OG + (size_t)trow * D + hh * 128 + vbo * 32 + 8 * g4 + 4 * h) = w; } } \
        _Pragma("unroll") for (int g4 = 0; g4 < 4; ++g4) { v2u w0, w1; w0.x = pk2(S0[4 * g4], S0[4 * g4 + 1]); w0.y = pk2(S0[4 * g4 + 2], S0[4 * g4 + 3]); w1.x = pk2(S1[4 * g4], S1[4 * g4 + 1]); w1.y = pk2(S1[4 * g4 + 2], S1[4 * g4 + 3]); \
            *(LAS v2u*)(lds + GL_ST + (vb0 * 32 + l31) * GS_R + (kb * 32 + 8 * g4 + 4 * h) * 2) = w0; *(LAS v2u*)(lds + GL_ST + ((vb0 + 1) * 32 + l31) * GS_R + (kb * 32 + 8 * g4 + 4 * h) * 2) = w1; } \
        if ((c) + 1 < 32) GLA_STORE(X); \
        GLA_LOAD(X, (c) + 3); GLA_GS(G, (c) + 2); \
    } while (0)
    GLA_LOAD(B, 0); GLA_STORE(B);
    GLA_LOAD(A, 1); GLA_LOAD(B, 2); GLA_GS(gsE, 0); GLA_GS(gsO, 1);
    for (int c = 0; c < 32; c += 2) {
        GLA_CHUNK(c, A, gsE);
        GLA_CHUNK(c + 1, B, gsO);
    }
#undef GLA_LOAD
#undef GLA_STORE
#undef GLA_GS
#undef GLA_CHUNK
    float* so = state_out + ((size_t)(b * 32 + hh) * 128 + kb * 32) * 128 + vb0 * 32 + l31;
#pragma unroll
    for (int r = 0; r < 16; ++r) { so[(size_t)crow(r, h) * 128] = S0[r]; so[(size_t)crow(r, h) * 128 + 32] = S1[r]; }
}
__device__ __forceinline__ void gla_sample_unit(LAS unsigned char* lds, const float* sraw, const float* st_in, const float* lb, const float* nw, bf16* OG, float* st_out, int sb, int hh, int tid, int wave, int lane) {
    LAS float* fk = (LAS float*)lds; LAS float* kk = fk + 128; LAS float* qv = kk + 128; LAS float* iv = qv + 128; LAS float* part = iv + 128; LAS float* red = part + 512;
    __syncthreads();
    const float* sr = sraw + (size_t)sb * NHG + hh * 128;
    if (tid < 128) { const float q = sr[tid], f = sr[D + tid], x = sr[2 * D + tid]; const float l = lb[hh * 128 + tid]; const float k1 = (1.0f - l) * fast_rcp(1.0f + __expf(f));
        fk[tid] = 1.0f - k1; kk[tid] = k1; qv[tid] = siluf_(q) * 0.08838834764831845f; iv[tid] = x; }
    __syncthreads();
    const int v = tid & 127, kg = tid >> 7; const size_t base = ((size_t)(sb * 32 + hh) * 128 + kg * 32) * 128 + v; const float xi = iv[v]; float op = 0.f;
    float s0v[32];
#pragma unroll
    for (int k = 0; k < 32; ++k) s0v[k] = __builtin_nontemporal_load(st_in + base + (size_t)k * 128);
#pragma unroll
    for (int k = 0; k < 32; ++k) { const float s = fk[kg * 32 + k] * s0v[k] + kk[kg * 32 + k] * xi; __builtin_nontemporal_store(s, st_out + base + (size_t)k * 128); op += qv[kg * 32 + k] * s; }
    part[kg * 128 + v] = op;
    __syncthreads();
    float o = 0.f;
    if (tid < 128) { o = (part[tid] + part[128 + tid]) + (part[256 + tid] + part[384 + tid]); const float ws = wave_sum(o * o); if (lane == 0) red[wave] = ws; }
    __syncthreads();
    if (tid < 128) { const float rstd = __builtin_amdgcn_rsqf((red[0] + red[1]) * (1.0f / 128.0f) + RMS_EPS); const float g = sr[3 * D + tid];
        OG[(size_t)(MP + sb) * D + hh * 128 + tid] = (bf16)(pk2(o * rstd * nw[tid] * siluf_(g), 0.f) & 0xffffu); }
}

struct Args { const float* in[19]; float* out; unsigned char* ws; int ph_lo, ph_hi, li, pad; };
enum { I_XP = 0, I_XS, I_CK, I_CV, I_ST, I_NMIX, I_NFFN, I_NFIN, I_WQKV, I_BQKV, I_SINK, I_WO, I_BO, I_HWIN, I_HLB, I_HNORM, I_HWO, I_FWIN, I_FWOUT };

template <class Epi, bool I8 = false> __device__ __forceinline__ void run_gemm(LAS unsigned char* lds, const bf16* A, const bf16* Bt, int N, int K, const Epi& E, int Gn = (int)gridDim.x, int cn = (int)blockIdx.x, int nx = pg8::NXCD) {
    pg8::Gemm g{A, Bt, MP, N, K}; pg8::StaticOrder S; S.init(MP, N, Gn, cn, nx);
    pg8::gemm_phase<Epi, pg8::StaticOrder, true, true, I8>(lds, g, S, E);
}
__device__ __forceinline__ void sample_deal(int nwg, int& u0, int& ustep) { const int G = (int)gridDim.x, first = nwg % G; if (first == 0) { u0 = (int)blockIdx.x; ustep = G; } else { u0 = (int)blockIdx.x >= first ? (int)blockIdx.x - first : (1 << 30); ustep = G - first; } }
__device__ __forceinline__ void sample_res(LAS unsigned char* lds, const bf16* A, int K, const bf16* Bt, bf16* xb, float* out, const float* bias, ssq_t* ss, int tid, int wave, int lane) {
    const int row = tid >> 4, n = tid & 15;
    SampleA sa; const bool resident = (K == D) && (int)blockIdx.x < D / 16; if (resident) sample_load_a(sa, A, wave, lane);
    for (int u = blockIdx.x; u < D / 16; u += gridDim.x) { float r[1];
        if (K == D) sgemm_unit_ra<1>(sa, Bt + (size_t)u * 16 * K, Bt + (size_t)u * 16 * K, (LAS float*)lds, wave, lane, tid, r); else sgemm_unit<1>(A, K, Bt + (size_t)u * 16 * K, Bt + (size_t)u * 16 * K, (LAS float*)lds, wave, lane, tid, r);
        const int col = u * 16 + n; const size_t off = (size_t)row * D + col; float x = bf2f(xb[off]) + r[0] + (bias ? bias[col] : 0.f);
        if (out) out[off] = x; else { const bf16 xr = (bf16)(pk2(x, 0.f) & 0xffffu); xb[off] = xr; x = bf2f(xr); }
        float sq = x * x; sq += __shfl_xor(sq, 1); sq += __shfl_xor(sq, 2); sq += __shfl_xor(sq, 4); sq += __shfl_xor(sq, 8);
        if (n == 0) __hip_atomic_fetch_add(ss + row, ss_fix(sq), RLX_AGENT); }
}
__device__ __forceinline__ void sample_res_ksplit(LAS unsigned char* lds, volatile LAS unsigned* flagw, const bf16* A, const bf16* Bt, bf16* xb, ssq_t* ss, float* part, unsigned* cnt, int tid, int wave, int lane) {
    constexpr int KC = DFF / 8, NST = KC / 32;
    static_assert(KC * 8 == DFF && NST * 32 == KC, "K-chunks of whole 32-k steps");
    const int bx = (int)blockIdx.x, kc = bx & 7, nb = bx >> 3, fr = lane & 15, fq = lane >> 4;
    constexpr int NFW = (2 * NST + NWAVES - 1) / NWAVES; v4u af[NFW];
#pragma unroll
    for (int i = 0; i < NFW; ++i) { const int f = wave + i * NWAVES, fc = f < 2 * NST ? f : 0, t = fc >> 1, h = fc & 1;
        af[i] = *(const v4u*)(A + (size_t)(16 * h + fr) * DFF + kc * KC + t * 32 + fq * 8); }
    const bf16* bp = Bt + (size_t)(nb * 128 + wave * 16 + fr) * DFF + kc * KC + fq * 8;
    bf16x8 b[NST];
#pragma unroll
    for (int t = 0; t < NST / 2; ++t) b[t] = *(const bf16x8*)(bp + t * 32);
#pragma unroll
    for (int i = 0; i < NFW; ++i) { const int f = wave + i * NWAVES; if (f < 2 * NST) *(LAS v4u*)(lds + f * 1024 + lane * 16) = af[i]; }
#pragma unroll
    for (int t = NST / 2; t < NST; ++t) b[t] = *(const bf16x8*)(bp + t * 32);
    __syncthreads();
    f32x4 c0 = (f32x4){0.f, 0.f, 0.f, 0.f}, c1 = (f32x4){0.f, 0.f, 0.f, 0.f};
#pragma unroll
    for (int t = 0; t < NST; ++t) { const bf16x8 a0 = *(const LAS bf16x8*)(lds + (2 * t) * 1024 + lane * 16), a1 = *(const LAS bf16x8*)(lds + (2 * t + 1) * 1024 + lane * 16);
        c0 = MFMA16(b[t], a0, c0); c1 = MFMA16(b[t], a1, c1); }
    { float* pp = part + ((size_t)kc * MS + fr) * D + nb * 128 + wave * 16 + 4 * fq; *(f32x4*)pp = c0; *(f32x4*)(pp + (size_t)16 * D) = c1; }
    asm volatile("s_waitcnt vmcnt(0)" ::: "memory");
    __syncthreads();
    if (tid == 0) { __builtin_amdgcn_fence(__ATOMIC_RELEASE, "agent"); asm volatile("s_waitcnt vmcnt(0)" ::: "memory");
        const unsigned old = xb_add(cnt + nb, 1u); unsigned last = 0u;
        if (old == 7u) { __builtin_amdgcn_fence(__ATOMIC_ACQUIRE, "agent"); asm volatile("s_waitcnt vmcnt(0)" ::: "memory"); last = 1u; }
        *flagw = last; }
    __syncthreads();
    if (*flagw) {
        const int row = tid >> 4, c8 = nb * 128 + (tid & 15) * 8; f32x4 s0 = (f32x4){0.f, 0.f, 0.f, 0.f}, s1 = s0;
#pragma unroll
        for (int k = 0; k < 8; ++k) { const float* pp = part + ((size_t)k * MS + row) * D + c8; s0 += *(const f32x4*)pp; s1 += *(const f32x4*)(pp + 4); }
        const v4u xr = *(const v4u*)(xb + (size_t)row * D + c8); const unsigned xw_[4] = {xr.x, xr.y, xr.z, xr.w}; float o[8];
#pragma unroll
        for (int e = 0; e < 8; ++e) { const float xv = __builtin_bit_cast(float, (e & 1) ? (xw_[e >> 1] & 0xffff0000u) : (xw_[e >> 1] << 16)); o[e] = xv + (e < 4 ? s0[e & 3] : s1[e & 3]); }
        v4u w; w.x = pk2(o[0], o[1]); w.y = pk2(o[2], o[3]); w.z = pk2(o[4], o[5]); w.w = pk2(o[6], o[7]); *(v4u*)(xb + (size_t)row * D + c8) = w;
        const unsigned ww_[4] = {w.x, w.y, w.z, w.w}; float sq = 0.f;
#pragma unroll
        for (int e = 0; e < 8; ++e) { const float xv = __builtin_bit_cast(float, (e & 1) ? (ww_[e >> 1] & 0xffff0000u) : (ww_[e >> 1] << 16)); sq += xv * xv; }
        sq += __shfl_xor(sq, 1); sq += __shfl_xor(sq, 2); sq += __shfl_xor(sq, 4); sq += __shfl_xor(sq, 8);
        if ((tid & 15) == 0) __hip_atomic_fetch_add(ss + row, ss_fix(sq), RLX_AGENT);
    }
    __syncthreads();
}
#ifndef FFI_IDLE_UNITS
#define FFI_IDLE_UNITS 5
#endif
__device__ __forceinline__ void sample_ffn_in(LAS unsigned char* lds, const bf16* A, const bf16* Bt, bf16* H, const ssq_t* ss, int tid, int wave, int lane) {
    const int row = tid >> 4, n = tid & 15;
    const int Gs = (int)gridDim.x, first = ((MP / 256) * (NFI / 256)) % Gs, nidle = first ? Gs - first : 0, nfast = nidle * FFI_IDLE_UNITS < DFF / 16 ? nidle * FFI_IDLE_UNITS : 0;
    int su0, sus, suend;
    if (nfast && (int)blockIdx.x >= first) { su0 = (int)blockIdx.x - first; sus = nidle; suend = nfast; } else if (nfast) { su0 = nfast + (int)blockIdx.x; sus = first; suend = DFF / 16; } else { su0 = (int)blockIdx.x; sus = Gs; suend = DFF / 16; }
    SampleA sa; if (su0 < suend) sample_load_a(sa, A, wave, lane);
    for (int u = su0; u < suend; u += sus) { const int j0 = u * 16; const bf16* bg = Bt + (size_t)(256 * (j0 >> 7) + (j0 & 127)) * D; float r[2];
        sgemm_unit_ra<2>(sa, bg, bg + (size_t)128 * D, (LAS float*)lds, wave, lane, tid, r);
        const float rs = ss_rstd(ss, row); H[(size_t)row * DFF + j0 + n] = (bf16)(pk2(siluf_(r[0] * rs) * (r[1] * rs), 0.f) & 0xffffu); }
}

__device__ __forceinline__ void sample_ffn_in_q(LAS unsigned char* lds, const signed char* A8, const signed char* Bq, bf16* H, const float* ra, const float* bs, int tid, int wave, int lane) {
    const int row = tid >> 4, n = tid & 15;
    const int Gs = (int)gridDim.x, first = ((MP / 256) * (NFI / 256)) % Gs, nidle = first ? Gs - first : 0, nfast = nidle * FFI_IDLE_UNITS < DFF / 16 ? nidle * FFI_IDLE_UNITS : 0;
    int su0, sus, suend;
    if (nfast && (int)blockIdx.x >= first) { su0 = (int)blockIdx.x - first; sus = nidle; suend = nfast; } else if (nfast) { su0 = nfast + (int)blockIdx.x; sus = first; suend = DFF / 16; } else { su0 = (int)blockIdx.x; sus = Gs; suend = DFF / 16; }
    SampleA8 sa; if (su0 < suend) sample_load_a8(sa, A8, wave, lane);
    const float rs = ra[row];
    for (int u = su0; u < suend; u += sus) { const int j0 = u * 16, wr0 = 256 * (j0 >> 7) + (j0 & 127); const signed char* bg = Bq + (size_t)wr0 * D; float r[2];
        sgemm_unit_i8x2(sa, bg, bg + (size_t)128 * D, (LAS float*)lds, wave, lane, tid, r);
        H[(size_t)row * DFF + j0 + n] = (bf16)(pk2(siluf_(r[0] * (rs * bs[wr0 + n])) * (r[1] * (rs * bs[wr0 + 128 + n])), 0.f) & 0xffffu); }
}

#define PTR64(k) ({ const unsigned long long v_ = ptab[k]; ((unsigned long long)(unsigned)__builtin_amdgcn_readfirstlane((int)(v_ >> 32)) << 32) | (unsigned)__builtin_amdgcn_readfirstlane((int)v_); })
#define PIN(k) ((const float*)(const GAS float*)PTR64(k))
constexpr int CI0 = (D / 64) * (QKVN / 32), CI1 = (D / 64) * (D / 32), CI2 = (D / 64) * (NFI / 32), CI3 = (DFF / 64) * (D / 32), CI4 = (D / 64) * (NHG / 32);
constexpr int CO_WO = CI0, CO_FI0 = CO_WO + CI1, CO_FO0 = CO_FI0 + CI2, CO_HI = CO_FO0 + CI3, CO_HO = CO_HI + CI4, CO_FI1 = CO_HO + CI1, CO_FO1 = CO_FI1 + CI2, CO_END = CO_FO1 + CI3;
__device__ __forceinline__ CvItem cv_lookup(volatile LAS unsigned long long* ptab, int it) {
    unsigned char* ws = (unsigned char*)(GAS unsigned char*)PTR64(20); CvItem c; int r = it;
    if (r < CO_WO)       { c.W = PIN(I_WQKV); c.K = D; c.N = QKVN; c.WT = (bf16*)(ws + WS_WQKV); c.map = 0; c.kw = PIN(I_NMIX); }
    else if (r < CO_FI0) { r -= CO_WO;  c.W = PIN(I_WO); c.K = D; c.N = D; c.WT = (bf16*)(ws + WS_WO); c.map = 0; c.kw = nullptr; }
    else if (r < CO_FO0) { r -= CO_FI0; c.W = PIN(I_FWIN); c.K = D; c.N = NFI; c.WT = (bf16*)(ws + WS_WFI0); c.map = 1; c.kw = PIN(I_NFFN); }
    else if (r < CO_HI)  { r -= CO_FO0; c.W = PIN(I_FWOUT); c.K = DFF; c.N = D; c.WT = (bf16*)(ws + WS_WFO0); c.map = 0; c.kw = nullptr; }
    else if (r < CO_HO)  { r -= CO_HI;  c.W = PIN(I_HWIN); c.K = D; c.N = NHG; c.WT = (bf16*)(ws + WS_WHI); c.map = 2; c.kw = PIN(I_NMIX) + D; }
    else if (r < CO_FI1) { r -= CO_HO;  c.W = PIN(I_HWO); c.K = D; c.N = D; c.WT = (bf16*)(ws + WS_WHO); c.map = 0; c.kw = nullptr; }
    else if (r < CO_FO1) { r -= CO_FI1; c.W = PIN(I_FWIN) + (size_t)D * NFI; c.K = D; c.N = NFI; c.WT = (bf16*)(ws + WS_WFI1); c.map = 1; c.kw = PIN(I_NFFN) + D; }
    else                 { r -= CO_FO1; c.W = PIN(I_FWOUT) + (size_t)DFF * D; c.K = DFF; c.N = D; c.WT = (bf16*)(ws + WS_WFO1); c.map = 0; c.kw = nullptr; }
    c.item = r; return c;
}
__device__ __forceinline__ void convert_items(volatile LAS unsigned long long* ptab, int lo, int hi, int worker, int nworkers, LAS float* scr, int lane) {
    for (int it = lo + worker; it < hi; it += 2 * nworkers) {
        const bool two = it + nworkers < hi;
        const CvItem ca = cv_lookup(ptab, it), cb = cv_lookup(ptab, two ? it + nworkers : it);
        float va[32], vb[32], ka, kb_;
        cv_load(ca, lane, va, ka);
        if (two) cv_load(cb, lane, vb, kb_);
        cv_store(ca, lane, va, ka, scr);
        if (two) cv_store(cb, lane, vb, kb_, scr);
    }
}
#ifndef CV_S7
#define CV_S7 8192
#endif
constexpr int S7_LO = CO_HO, S7_HI = CO_HO + CV_S7;
static_assert(S7_HI <= CO_FO1, "the P7 slot holds only weights that are first used after P7");
#ifndef CV_SPLIT
#define CV_SPLIT CO_WO
#endif
static_assert(CV_SPLIT >= CO_WO && (CV_SPLIT <= S7_LO || CV_SPLIT >= S7_HI), "P0 converts items [0, CV_SPLIT), P1's conversion half the rest");

__global__ void __launch_bounds__(NWAVES * 64, 2) fwd_kernel(Args args) {
    extern __shared__ __attribute__((aligned(16))) unsigned char lds_raw[];
    LAS unsigned char* lds = (LAS unsigned char*)lds_raw;
    volatile LAS unsigned* MISC = (volatile LAS unsigned*)(lds + MISC_OFF);
    const int tid = threadIdx.x, lane = tid & 63, wave = __builtin_amdgcn_readfirstlane(tid >> 6);
    const int G = gridDim.x; const int bx = blockIdx.x; const int vcu = (G % 8 == 0) ? (bx % 8) * (G / 8) + bx / 8 : bx;
    unsigned char* ws = args.ws;
    gu32* ctl = (gu32*)(ws + WS_CTL);
    for (int u = tid; u < (LDS_BYTES - LDSCTL_OFF) / 4; u += NWAVES * 64) ((LAS unsigned*)(lds + LDSCTL_OFF))[u] = 0u;
    __syncthreads();
    volatile LAS unsigned long long* ptab = (volatile LAS unsigned long long*)(lds + PTAB_OFF);
    if (tid == 0) {
#pragma unroll
        for (int k = 0; k < 19; ++k) ptab[k] = (unsigned long long)args.in[k];
        ptab[19] = (unsigned long long)args.out; ptab[20] = (unsigned long long)args.ws; }
    __syncthreads();
    XcdBarrier bar; bar.bar = (unsigned*)(ctl + CW_BAR); bar.x = 0; bar.st = nullptr;
    if (N_LAUNCHES == 1) bar = xcd_barrier_post((unsigned*)(ctl + CW_BAR), MISC + 8);
#define GRID_BAR() do { if (N_LAUNCHES == 1) xcd_barrier(bar); } while (0)
    const int lo = args.ph_lo, hi = args.ph_hi;
#ifdef ONLY_PHASE
#define IN(k) ((k) == ONLY_PHASE && lo <= (k) && (k) < hi)
#else
#define IN(k) (lo <= (k) && (k) < hi)
#endif
#define BOTH(k) (IN(k) && IN((k) + 1))
#ifndef REPMASK
#define REPMASK 0
#endif
#ifndef REPN
#define REPN 1
#endif
#define REPEAT(k) for (int rep_ = 0; rep_ < (((REPMASK) >> (k)) & 1) * (REPN) + 1; ++rep_)
#define WSB ((unsigned char*)(GAS unsigned char*)PTR64(20))
#define WQKV ((bf16*)(WSB + WS_WQKV))
#define WO ((bf16*)(WSB + WS_WO))
#define WFI0 ((bf16*)(WSB + WS_WFI0))
#define WFO0 ((bf16*)(WSB + WS_WFO0))
#define WHI ((bf16*)(WSB + WS_WHI))
#define WHO ((bf16*)(WSB + WS_WHO))
#define WFI1 ((bf16*)(WSB + WS_WFI1))
#define WFO1 ((bf16*)(WSB + WS_WFO1))
#define XB ((bf16*)(WSB + WS_XN))
#define Qb ((bf16*)(WSB + WS_Q))
#define Kb ((bf16*)(WSB + WS_K))
#define Vb ((bf16*)(WSB + WS_V))
#define Ob ((bf16*)(WSB + WS_O))
#define Hb ((bf16*)(WSB + WS_H))
#define QT ((bf16*)(WSB + WS_QT))
#define KT ((bf16*)(WSB + WS_KT))
#define KP ((bf16*)(WSB + WS_KP))
#define VI ((bf16*)(WSB + WS_VI))
#define GSb ((bf16*)(WSB + WS_GS))
#define DEC ((float*)(WSB + WS_DEC))
#define SRAW ((float*)(WSB + WS_SRAW))
#define LB ((float*)(WSB + WS_LB))
#define XQ ((signed char*)(WSB + WS_XQ))
#define XQS ((signed char*)(WSB + WS_RA + 65536))
#define RA ((float*)(WSB + WS_RA))
#define WQ1 ((signed char*)(WSB + WS_WQ1))
#define BSC ((float*)(WSB + WS_BSC))
#define WQ0 ((signed char*)(WSB + WS_WQ0))
#define WQO ((signed char*)(WSB + WS_WQO))
#define WQQ ((signed char*)(WSB + WS_WQQ))
#define BSCQ ((float*)(WSB + WS_BSCQ))
#define BSCO ((float*)(WSB + WS_BSCO))
#define BSC0 ((float*)(WSB + WS_BSC0))
#define SSB(k) ((ssq_t*)(WSB + WS_CTL + CW_SS * 4) + (k) * SS_STRIDE)
#define SS0 SSB(0)
#define SS1 SSB(1)
#define SS2 SSB(2)
#define SS3 SSB(3)
#define SS4 SSB(4)
#define out ((float*)(GAS float*)PTR64(19))

    if (IN(0)) REPEAT(0) {
        LAS float* scr = (LAS float*)(lds + RING_OFF + wave * 16384);
        const int gw = vcu * NWAVES + wave, NGW = G * NWAVES;
        convert_items(ptab, 0, CV_SPLIT < S7_LO ? CV_SPLIT : S7_LO, gw, NGW, scr, lane);
        if (CV_SPLIT > S7_HI) convert_items(ptab, S7_HI, CV_SPLIT, gw, NGW, scr, lane);
        for (int m = gw; m < MT; m += NGW) row_to_bf16_ss(m < MP ? PIN(I_XP) + (size_t)m * D : PIN(I_XS) + (size_t)(m - MP) * D, XB + (size_t)m * D, SS0 + m, lane, m < MP ? XQ + (size_t)m * D : nullptr, RA + (m < MP ? m : 0));
        if (bx == 0) for (int c = tid; c < D; c += NWAVES * 64) LB[c] = fast_rcp(1.0f + __expf(PIN(I_HLB)[c] - PIN(I_HLB)[D + c]));
        if (BOTH(0)) GRID_BAR();
    }
    if (IN(1)) REPEAT(1) {
        const int GH = G / 2; const bool gemm_side = (bx & 1) == 0; const int hidx = ((bx & 7) >> 1) + 4 * (bx >> 3);
        if (gemm_side) {
            unsigned* sideA = (unsigned*)(ctl + CW_SIDE_A); unsigned* tmo = (unsigned*)(ctl + CW_BAR) + XB_TMO;
            quant_rows_i8(hidx * NWAVES + wave, D, GH * NWAVES, lane, [&](int r, const bf16*& sp, signed char*& dp, float*& sc, float& ex) { sp = WQKV + (size_t)r * D; dp = WQQ + (size_t)r * D; sc = BSCQ + r; ex = 1.0f; });
            side_barrier(sideA, GH, tmo);
            { EpiQKVT<true> E{Qb, Kb, Vb, PIN(I_BQKV), out + OUT_WKP, out + OUT_WVP, SS0, RA, BSCQ, 0}; run_gemm<EpiQKVT<true>, true>(lds + RING_OFF, (const bf16*)XQ, (const bf16*)WQQ, D, D / 2, E, GH, hidx, 4); }
            { EpiQKVT<false> E{Qb, Kb, Vb, PIN(I_BQKV), out + OUT_WKP, out + OUT_WVP, SS0, nullptr, nullptr, 16}; run_gemm(lds + RING_OFF, XB, WQKV + (size_t)D * D, 2 * KVD, D, E, GH, hidx, 4); }
            const int row = tid >> 4, n = tid & 15;
            SampleA sa; if (hidx < QKVN / 16) sample_load_a(sa, XB + (size_t)MP * D, wave, lane);
            for (int u = hidx; u < QKVN / 16; u += GH) { float r[1]; sgemm_unit_ra<1>(sa, WQKV + (size_t)u * 16 * D, WQKV + (size_t)u * 16 * D, (LAS float*)lds, wave, lane, tid, r);
                const int col = u * 16 + n; const float v = r[0] * ss_rstd(SS0, MP + row) + PIN(I_BQKV)[col]; const bf16 vb = (bf16)(pk2(v, 0.f) & 0xffffu);
                if (col < D) Qb[(size_t)(MP + row) * D + col] = vb;
                else if (col < D + KVD) { Kb[(size_t)(MP + row) * KVD + col - D] = vb; out[OUT_WKS + ((size_t)row * 128 + 127) * KVD + col - D] = v; }
                else { Vb[(size_t)(MP + row) * KVD + col - D - KVD] = vb; out[OUT_WVS + ((size_t)row * 128 + 127) * KVD + col - D - KVD] = v; } }
            side_barrier(sideA, 2 * GH, tmo);
            { AttnKV kv; if (hidx < NBATCH * 16 * 8) attn_kv_load(kv, Kb, Vb, hidx >> 7, hidx & 7, (hidx >> 3) & 15, tid);
              for (int u = hidx; u < NBATCH * 16 * 8; u += GH) { const int hkv = u & 7, n = (u >> 3) & 15, b = u >> 7; const int un = u + GH; const bool hn = un < NBATCH * 16 * 8;
                  attn_prompt_unit(lds + RING_OFF, Qb, Kb, Vb, Ob, PIN(I_SINK), b, hkv, n, kv, hn, un >> 7, un & 7, (un >> 3) & 15, tid, wave, lane); } }
            for (int u = hidx; u < MS * 8; u += GH) attn_sample_unit(lds + RING_OFF, Qb, Kb, Vb, Ob, PIN(I_SINK), PIN(I_CK), PIN(I_CV), out + OUT_WKS, out + OUT_WVS, u >> 3, u & 7, tid, wave, lane);
            side_barrier(sideA, 3 * GH, tmo);
            quant_rows_i8(hidx * NWAVES + wave, MP, GH * NWAVES, lane, [&](int r, const bf16*& sp, signed char*& dp, float*& sc, float& ex) { sp = Ob + (size_t)r * D; dp = XQ + (size_t)r * D; sc = RA + r; ex = 1.0f; });
        } else {
            LAS float* scr = (LAS float*)(lds + RING_OFF + wave * 16384); const int wk = hidx * NWAVES + wave, nwk = (G - GH) * NWAVES;
            if (CV_SPLIT < S7_LO) convert_items(ptab, CV_SPLIT, S7_LO, wk, nwk, scr, lane);
            convert_items(ptab, CV_SPLIT > S7_HI ? CV_SPLIT : S7_HI, CO_END, wk, nwk, scr, lane);
        }
        if (BOTH(1)) GRID_BAR();
    }
    if (IN(2)) REPEAT(2) {
        quant_rows_i8(vcu * NWAVES + wave, NFI, G * NWAVES, lane, [&](int r, const bf16*& sp, signed char*& dp, float*& sc, float& ex) { sp = WFI0 + (size_t)r * D; dp = WQ0 + (size_t)r * D; sc = BSC0 + r; ex = 1.0f; });
        quant_rows_i8(vcu * NWAVES + wave, D, G * NWAVES, lane, [&](int r, const bf16*& sp, signed char*& dp, float*& sc, float& ex) { sp = WO + (size_t)r * D; dp = WQO + (size_t)r * D; sc = BSCO + r; ex = 1.0f; });
        __syncthreads();
        if (BOTH(2)) GRID_BAR();
    }
    if (IN(3)) {
        { EpiResT<true> E{XB, nullptr, PIN(I_BO), SS1, RA, BSCO}; run_gemm<EpiResT<true>, true>(lds + RING_OFF, (const bf16*)XQ, (const bf16*)WQO, D, D / 2, E); }
        sample_res(lds + RING_OFF, Ob + (size_t)MP * D, D, WO, XB + (size_t)MP * D, nullptr, PIN(I_BO), SS1 + MP, tid, wave, lane);
        if (BOTH(3)) GRID_BAR();
    }
    if (IN(4)) REPEAT(4) {
        quant_rows_i8(vcu * NWAVES + wave, MT, G * NWAVES, lane, [&](int r, const bf16*& sp, signed char*& dp, float*& sc, float& ex) { sp = XB + (size_t)r * D; dp = r < MP ? XQ + (size_t)r * D : XQS + (size_t)(r - MP) * D; sc = RA + r; ex = ss_rstd(SS1, r); });
        GRID_BAR();
        { EpiSwiGLUQ E{Hb, RA, BSC0}; run_gemm<EpiSwiGLUQ, true>(lds + RING_OFF, (const bf16*)XQ, (const bf16*)WQ0, NFI, D / 2, E); }
        sample_ffn_in_q(lds + RING_OFF, XQS, WQ0, Hb + (size_t)MP * DFF, RA + MP, BSC0, tid, wave, lane);
        if (BOTH(4)) GRID_BAR();
    }
    if (IN(5)) {
        { EpiRes E{XB, nullptr, nullptr, SS2}; run_gemm(lds + RING_OFF, Hb, WFO0, D, DFF, E); }
        if (G == 256) sample_res_ksplit(lds + RING_OFF, MISC + 12, Hb + (size_t)MP * DFF, WFO0, XB + (size_t)MP * D, SS2 + MP, (float*)(WSB + WS_PART), (unsigned*)(ctl + CW_SRES), tid, wave, lane);
        else sample_res(lds + RING_OFF, Hb + (size_t)MP * DFF, DFF, WFO0, XB + (size_t)MP * D, nullptr, nullptr, SS2 + MP, tid, wave, lane);
        if (BOTH(5)) GRID_BAR();
    }
    if (IN(6)) REPEAT(6) {
        { EpiHgrnIn E{QT, KT, VI, GSb, DEC, LB, SS2}; run_gemm(lds + RING_OFF, XB, WHI, NHG, D, E); }
        const int row = tid >> 4, n = tid & 15;
        SampleA sa; sample_load_a(sa, XB + (size_t)MP * D, wave, lane);
        for (int u = bx; u < NHG / 16; u += G) { float r[1]; sgemm_unit_ra<1>(sa, WHI + (size_t)u * 16 * D, WHI + (size_t)u * 16 * D, (LAS float*)lds, wave, lane, tid, r);
            const int R = u * 16, tile = R >> 8, w = R & 255; const int c0 = ((tile & 4) ? 2 * D : 0) + (w < 128 ? 0 : D) + (4 * (tile >> 3) + (tile & 3)) * 128 + (w & 127);
            const float rs = ss_rstd(SS2, MP + row); SRAW[(size_t)row * NHG + c0 + n] = r[0] * rs; }
        if (BOTH(6)) GRID_BAR();
    }
    if (IN(7)) REPEAT(7) {
        const int nseq = NBATCH * 32; const int half = G >= 2 * nseq ? nseq : 0;
        if (bx < nseq || half == 0) { for (int u = bx; u < nseq; u += (half ? nseq : G)) gla_prompt_seq(lds + RING_OFF, QT, KT, VI, GSb, DEC, PIN(I_HNORM), Ob, out + OUT_STP, u >> 5, u & 31, tid, wave, lane); }
        if (bx >= half) { for (int u = bx - half; u < MS * 32; u += G - half) gla_sample_unit(lds + RING_OFF, SRAW, PIN(I_ST), LB, PIN(I_HNORM), Ob, out + OUT_STS, u >> 5, u & 31, tid, wave, lane);
            if (half) { __syncthreads(); convert_items(ptab, S7_LO, S7_HI, (bx - half) * NWAVES + wave, (G - half) * NWAVES, (LAS float*)(lds + RING_OFF + wave * 16384), lane); }
            quant_rows_i8((bx - half) * NWAVES + wave, NFI, (G - half) * NWAVES, lane, [&](int r, const bf16*& sp, signed char*& dp, float*& sc, float& ex) { sp = WFI1 + (size_t)r * D; dp = WQ1 + (size_t)r * D; sc = BSC + r; ex = 1.0f; }); }
        __syncthreads();
        if (BOTH(7)) GRID_BAR();
    }
    if (IN(8)) {
        { EpiRes E{XB, nullptr, nullptr, SS3}; run_gemm(lds + RING_OFF, Ob, WHO, D, D, E); }
        sample_res(lds + RING_OFF, Ob + (size_t)MP * D, D, WHO, XB + (size_t)MP * D, nullptr, nullptr, SS3 + MP, tid, wave, lane);
        if (BOTH(8)) GRID_BAR();
    }
    if (IN(9)) REPEAT(9) {
        quant_rows_i8(vcu * NWAVES + wave, MT, G * NWAVES, lane, [&](int r, const bf16*& sp, signed char*& dp, float*& sc, float& ex) { sp = XB + (size_t)r * D; dp = r < MP ? XQ + (size_t)r * D : XQS + (size_t)(r - MP) * D; sc = RA + r; ex = ss_rstd(SS3, r); });
        GRID_BAR();
        { EpiSwiGLUQ E{Hb, RA, BSC}; run_gemm<EpiSwiGLUQ, true>(lds + RING_OFF, (const bf16*)XQ, (const bf16*)WQ1, NFI, D / 2, E); }
        sample_ffn_in_q(lds + RING_OFF, XQS, WQ1, Hb + (size_t)MP * DFF, RA + MP, BSC, tid, wave, lane);
        if (BOTH(9)) GRID_BAR();
    }
    if (IN(10)) {
        { EpiRes E{XB, nullptr, nullptr, SS4}; run_gemm(lds + RING_OFF, Hb, WFO1, D, DFF, E); }
        if (G == 256) sample_res_ksplit(lds + RING_OFF, MISC + 12, Hb + (size_t)MP * DFF, WFO1, XB + (size_t)MP * D, SS4 + MP, (float*)(WSB + WS_PART), (unsigned*)(ctl + CW_SRES) + 32, tid, wave, lane);
        else sample_res(lds + RING_OFF, Hb + (size_t)MP * DFF, DFF, WFO1, XB + (size_t)MP * D, nullptr, nullptr, SS4 + MP, tid, wave, lane);
        if (BOTH(10)) GRID_BAR();
    }
    if (IN(11)) {
        const float* nf = PIN(I_NFIN); const ssq_t* s3 = SS4;
        for (size_t i = (size_t)vcu * (NWAVES * 64) + tid; i < (size_t)MT * D / 8; i += (size_t)G * NWAVES * 64) { const int row = (int)(i >> 9), c8 = (int)(i & 511);
            const float rs = ss_rstd(s3, row); const v4u x = ((const v4u*)XB)[i]; const f32x4 w0 = ((const f32x4*)nf)[2 * c8], w1 = ((const f32x4*)nf)[2 * c8 + 1];
            f32x4 y0, y1; y0[0] = __builtin_bit_cast(float, x.x << 16); y0[1] = __builtin_bit_cast(float, x.x & 0xffff0000u); y0[2] = __builtin_bit_cast(float, x.y << 16); y0[3] = __builtin_bit_cast(float, x.y & 0xffff0000u);
            y1[0] = __builtin_bit_cast(float, x.z << 16); y1[1] = __builtin_bit_cast(float, x.z & 0xffff0000u); y1[2] = __builtin_bit_cast(float, x.w << 16); y1[3] = __builtin_bit_cast(float, x.w & 0xffff0000u);
            ((f32x4*)(out + OUT_Y))[2 * i] = y0 * rs * w0; ((f32x4*)(out + OUT_Y))[2 * i + 1] = y1 * rs * w1; }
    }
#undef IN
#undef BOTH
#undef GRID_BAR
#undef out
#undef WSB
#undef XQ
#undef XQS
#undef RA
#undef WQ1
#undef BSC
#undef WQ0
#undef WQO
#undef WQQ
#undef BSCQ
#undef BSCO
#undef BSC0
#undef WQKV
#undef WO
#undef WFI0
#undef WFO0
#undef WHI
#undef WHO
#undef WFI1
#undef WFO1
#undef XB
#undef Qb
#undef Kb
#undef Vb
#undef Ob
#undef Hb
#undef QT
#undef KT
#undef KP
#undef VI
#undef GSb
#undef DEC
#undef SRAW
#undef LB
#undef SSB
#undef SS0
#undef SS1
#undef SS2
#undef SS3
#undef SS4
}

extern "C" void kernel_launch(void* const* d_in, const int* in_sizes, int n_in, void* d_out, int out_size, void* d_ws, size_t ws_size, hipStream_t stream) {
    static int grid = 0;
    if (grid == 0) {
        if (n_in != 19 || (size_t)out_size != OUT_END || ws_size < WS_END) { fprintf(stderr, "kernel_launch: unexpected shapes (n_in %d, out %d, ws %zu); nothing launched\n", n_in, out_size, ws_size); grid = -1; return; }
        int dev = 0, cus = 0, per_cu = 0;
        if (hipGetDevice(&dev) != hipSuccess || hipDeviceGetAttribute(&cus, hipDeviceAttributeMultiprocessorCount, dev) != hipSuccess) { grid = -1; return; }
        if (hipFuncSetAttribute((const void*)fwd_kernel, hipFuncAttributeMaxDynamicSharedMemorySize, LDS_BYTES) != hipSuccess) { fprintf(stderr, "kernel_launch: hipFuncSetAttribute failed\n"); grid = -1; return; }
        if (hipOccupancyMaxActiveBlocksPerMultiprocessor(&per_cu, (const void*)fwd_kernel, NWAVES * 64, LDS_BYTES) != hipSuccess || per_cu < 1) { fprintf(stderr, "kernel_launch: occupancy query says %d blocks per CU\n", per_cu); }
        (void)hipGetLastError();
        grid = cus;
    }
    if (grid < 0) return;
    if (hipMemsetAsync((char*)d_ws + WS_CTL, 0, CTL_ZERO_BYTES, stream) != hipSuccess) { fprintf(stderr, "kernel_launch: memset failed\n"); return; }
    Args a{};
    for (int i = 0; i < 19; ++i) a.in[i] = (const float*)d_in[i];
    a.out = (float*)d_out; a.ws = (unsigned char*)d_ws;
    for (int li = 0; li < N_LAUNCHES; ++li) {
        a.ph_lo = (N_LAUNCHES == 1) ? 0 : li; a.ph_hi = (N_LAUNCHES == 1) ? NPHASE : li + 1; a.li = li; a.pad = 0;
        hipLaunchKernelGGL(fwd_kernel, dim3(grid), dim3(NWAVES * 64), LDS_BYTES, stream, a);
        const hipError_t le = hipPeekAtLastError();
        if (le != hipSuccess) { fprintf(stderr, "kernel_launch: launch %d failed: %s\n", li, hipGetErrorName(le)); break; }
    }
#ifdef EXTRA_PHASES
    { const int extra[] = {EXTRA_PHASES}; for (int e : extra) { a.ph_lo = e; a.ph_hi = e + 1; a.li = 1; hipLaunchKernelGGL(fwd_kernel, dim3(grid), dim3(NWAVES * 64), LDS_BYTES, stream, a); } }
#endif
#ifdef EXTRA_PHASES
    { const int extra[] = {EXTRA_PHASES}; for (int e : extra) { a.ph_lo = e; a.ph_hi = e + 1; a.li = 1; hipLaunchKernelGGL(fwd_kernel, dim3(grid), dim3(NWAVES * 64), LDS_BYTES, stream, a); } }
#endif
}
```
